# Optimizing an MI355X kernel written in HIP

```python
import math
import jax, jax.numpy as jnp
from jax import lax
import numpy as np

D_MODEL = 1024
BATCH = 4
SEQ = 4096
DEPTH = 2

MEM_LEN = 256
D_MIX = D_MODEL
SSD_DIM = D_MIX // 2
SSD_HEAD_DIM = 64
SSD_HEADS = SSD_DIM // SSD_HEAD_DIM
SSD_GROUPS = 2
SSD_STATE = 64
CONV_K = 4
CHUNK = 128
SB_DIM = D_MIX - SSD_DIM
SB_HEAD_DIM = 64
SB_HEADS = SB_DIM // SB_HEAD_DIM
Q_BLOCK = 128
XA_HEADS = 4
XA_HEAD_DIM = 128
XA_DIM = XA_HEADS * XA_HEAD_DIM
D_FF = 4 * D_MODEL
EPS = 1e-5
GN = SSD_GROUPS * SSD_STATE
CONV_DIM = SSD_DIM + 2 * GN
IN_DIM = SSD_DIM + CONV_DIM + SSD_HEADS + 3 * SB_DIM

kernel_name = "hymba_ssd_stickbreaking_memxattn_trunk"


def rmsnorm(x, g):
    xf = x.astype(jnp.float32)
    y = xf * lax.rsqrt(jnp.mean(xf * xf, axis=-1, keepdims=True) + EPS)
    return (y * g.astype(jnp.float32)).astype(x.dtype)


def causal_dwconv(x, w, b):
    y = lax.conv_general_dilated(
        x, w.astype(x.dtype)[:, None, :], window_strides=(1,), padding=[(CONV_K - 1, 0)],
        dimension_numbers=("NWC", "WIO", "NWC"), feature_group_count=x.shape[-1])
    return y + b.astype(x.dtype)


def ssd_chunked(xh, dt, a, bm, cm):
    b, s, h, p = xh.shape
    g, n = bm.shape[-2:]
    e = h // g
    nc = s // CHUNK
    x_c = (xh * dt[..., None]).reshape(b, nc, CHUNK, g, e, p)
    a_c = (dt * a).reshape(b, nc, CHUNK, g, e)
    b_c = bm.reshape(b, nc, CHUNK, g, n)
    c_c = cm.reshape(b, nc, CHUNK, g, n)
    a_cum = jnp.cumsum(a_c, axis=2)
    seg = a_cum[:, :, :, None] - a_cum[:, :, None, :]
    causal = jnp.tril(jnp.ones((CHUNK, CHUNK), dtype=bool))[:, :, None, None]
    decay = jnp.exp(jnp.where(causal, seg, -jnp.inf))
    cb = jnp.einsum("bclgn,bcsgn->bclsg", c_c, b_c)
    y_diag = jnp.einsum("bclsg,bclsge,bcsgep->bclgep", cb, decay, x_c)
    decay_states = jnp.exp(a_cum[:, :, -1:] - a_cum)
    states = jnp.einsum("bclgn,bclge,bclgep->bcgepn", b_c, decay_states, x_c)
    chunk_decay = jnp.exp(a_cum[:, :, -1])

    def step(prev, inp):
        st, dec = inp
        return prev * dec[..., None, None] + st, prev

    init = jnp.zeros((b, g, e, p, n), jnp.float32)
    _, prev_states = lax.scan(step, init, (jnp.swapaxes(states, 0, 1), jnp.swapaxes(chunk_decay, 0, 1)))
    prev_states = jnp.swapaxes(prev_states, 0, 1)
    y_off = jnp.einsum("bclgn,bcgepn,bclge->bclgep", c_c, prev_states, jnp.exp(a_cum))
    return (y_diag + y_off).reshape(b, s, h, p)


def stick_breaking_attention(q, k, v):
    s_len, dh = q.shape[2], q.shape[3]
    scale = 1.0 / math.sqrt(dh)
    outs = []
    for i in range(s_len // Q_BLOCK):
        start = i * Q_BLOCK
        end = start + Q_BLOCK
        qb = q[:, :, start:end].astype(jnp.float32)
        kb = k[:, :, :end].astype(jnp.float32)
        vb = v[:, :, :end].astype(jnp.float32)
        logits = jnp.einsum("bhqd,bhkd->bhqk", qb, kb) * scale
        t_pos = start + jnp.arange(Q_BLOCK)[:, None]
        s_pos = jnp.arange(end)[None, :]
        mask = s_pos < t_pos
        log_stay = jnp.where(mask, jax.nn.log_sigmoid(-logits), 0.0)
        log_beta = jax.nn.log_sigmoid(logits)
        later = lax.cumsum(log_stay, axis=3, reverse=True) - log_stay
        w = jnp.where(mask, jnp.exp(log_beta + later), 0.0)
        outs.append(jnp.einsum("bhqk,bhkd->bhqd", w, vb))
    return jnp.concatenate(outs, axis=2)


def hybrid_mixer(hn, w_in, conv_w, conv_b, dt_bias, a_log, d_skip, ssd_norm_g, sb_norm_g, w_out):
    b, s, _ = hn.shape
    proj = hn @ w_in.astype(hn.dtype)
    z, xbc, dt_raw, qkv = jnp.split(
        proj, [SSD_DIM, SSD_DIM + CONV_DIM, SSD_DIM + CONV_DIM + SSD_HEADS], axis=-1)
    xbc = jax.nn.silu(causal_dwconv(xbc, conv_w, conv_b))
    xs, bm, cm = jnp.split(xbc, [SSD_DIM, SSD_DIM + GN], axis=-1)
    dt = jax.nn.softplus(dt_raw.astype(jnp.float32) + dt_bias.astype(jnp.float32))
    a = -jnp.exp(a_log.astype(jnp.float32))
    xh = xs.astype(jnp.float32).reshape(b, s, SSD_HEADS, SSD_HEAD_DIM)
    y = ssd_chunked(xh, dt, a,
                    bm.astype(jnp.float32).reshape(b, s, SSD_GROUPS, SSD_STATE),
                    cm.astype(jnp.float32).reshape(b, s, SSD_GROUPS, SSD_STATE))
    y = y + d_skip.astype(jnp.float32)[:, None] * xh
    y = y.reshape(b, s, SSD_DIM) * jax.nn.silu(z.astype(jnp.float32))
    y_ssd = rmsnorm(y, ssd_norm_g)
    q, k, v = jnp.split(qkv, 3, axis=-1)
    to_heads = lambda t: t.reshape(b, s, SB_HEADS, SB_HEAD_DIM).transpose(0, 2, 1, 3)
    o = stick_breaking_attention(to_heads(q), to_heads(k), to_heads(v))
    y_sb = rmsnorm(o.transpose(0, 2, 1, 3).reshape(b, s, SB_DIM), sb_norm_g)
    y_all = jnp.concatenate([y_ssd, y_sb], axis=-1).astype(hn.dtype)
    return y_all @ w_out.astype(hn.dtype)


def memory_cross_attention(hn, mem, g_mem, w_q, w_k, w_v, w_o):
    b, s, _ = hn.shape
    m = rmsnorm(mem, g_mem)
    q = (hn @ w_q.astype(hn.dtype)).reshape(b, s, XA_HEADS, XA_HEAD_DIM).astype(jnp.float32)
    k = (m @ w_k.astype(m.dtype)).reshape(b, -1, XA_HEADS, XA_HEAD_DIM).astype(jnp.float32)
    v = (m @ w_v.astype(m.dtype)).reshape(b, -1, XA_HEADS, XA_HEAD_DIM).astype(jnp.float32)
    logits = jnp.einsum("bshd,bmhd->bhsm", q, k) * (1.0 / math.sqrt(XA_HEAD_DIM))
    p = jax.nn.softmax(logits, axis=-1)
    o = jnp.einsum("bhsm,bmhd->bshd", p, v).reshape(b, s, XA_DIM).astype(hn.dtype)
    return o @ w_o.astype(hn.dtype)


def sqrelu_mlp(hn, w1, w2):
    u = hn @ w1.astype(hn.dtype)
    u = jnp.square(jax.nn.relu(u))
    return u @ w2.astype(hn.dtype)


def setup_inputs(seed: int = 0) -> dict:
    key = jax.random.key(seed)
    ks = jax.random.split(key, 24)
    f32 = jnp.float32
    nrm = lambda k, shape, fan_in: jax.random.normal(k, shape, f32) * (fan_in ** -0.5)
    gain = lambda k, shape: 1.0 + 0.02 * jax.random.normal(k, shape, f32)
    u = jax.random.uniform(ks[5], (DEPTH, SSD_HEADS), f32)
    dt0 = jnp.exp(u * (math.log(0.1) - math.log(0.001)) + math.log(0.001))
    dt_bias = dt0 + jnp.log(-jnp.expm1(-dt0))
    a_log = jnp.log(jax.random.uniform(ks[6], (DEPTH, SSD_HEADS), f32, minval=1.0, maxval=16.0))
    return {
        "x": jax.random.normal(ks[0], (BATCH, SEQ, D_MODEL), f32),
        "mem": jax.random.normal(ks[1], (BATCH, MEM_LEN, D_MODEL), f32),
        "norm_mix_g": gain(ks[2], (DEPTH, D_MODEL)),
        "w_in": nrm(ks[3], (DEPTH, D_MODEL, IN_DIM), D_MODEL),
        "conv_w": 0.5 * jax.random.normal(ks[4], (DEPTH, CONV_K, CONV_DIM), f32),
        "conv_b": 0.02 * jax.random.normal(ks[7], (DEPTH, CONV_DIM), f32),
        "dt_bias": dt_bias,
        "a_log": a_log,
        "d_skip": 1.0 + 0.1 * jax.random.normal(ks[8], (DEPTH, SSD_HEADS), f32),
        "ssd_norm_g": gain(ks[9], (DEPTH, SSD_DIM)),
        "sb_norm_g": gain(ks[10], (DEPTH, SB_DIM)),
        "w_out": nrm(ks[11], (DEPTH, D_MIX, D_MODEL), D_MIX),
        "norm_xa_g": gain(ks[12], (DEPTH, D_MODEL)),
        "norm_mem_g": gain(ks[13], (DEPTH, D_MODEL)),
        "w_xq": nrm(ks[14], (DEPTH, D_MODEL, XA_DIM), D_MODEL),
        "w_xk": nrm(ks[15], (DEPTH, D_MODEL, XA_DIM), D_MODEL),
        "w_xv": nrm(ks[16], (DEPTH, D_MODEL, XA_DIM), D_MODEL),
        "w_xo": nrm(ks[17], (DEPTH, XA_DIM, D_MODEL), XA_DIM),
        "norm_ff_g": gain(ks[18], (DEPTH, D_MODEL)),
        "w_ff1": nrm(ks[19], (DEPTH, D_MODEL, D_FF), D_MODEL),
        "w_ff2": nrm(ks[20], (DEPTH, D_FF, D_MODEL), D_FF),
        "final_g": gain(ks[21], (D_MODEL,)),
    }


def reference(x, mem, norm_mix_g, w_in, conv_w, conv_b, dt_bias, a_log, d_skip, ssd_norm_g,
              sb_norm_g, w_out, norm_xa_g, norm_mem_g, w_xq, w_xk, w_xv, w_xo,
              norm_ff_g, w_ff1, w_ff2, final_g):
    h = x
    for l in range(DEPTH):
        h = h + hybrid_mixer(rmsnorm(h, norm_mix_g[l]), w_in[l], conv_w[l], conv_b[l], dt_bias[l],
                             a_log[l], d_skip[l], ssd_norm_g[l], sb_norm_g[l], w_out[l])
        h = h + memory_cross_attention(rmsnorm(h, norm_xa_g[l]), mem, norm_mem_g[l],
                                       w_xq[l], w_xk[l], w_xv[l], w_xo[l])
        h = h + sqrelu_mlp(rmsnorm(h, norm_ff_g[l]), w_ff1[l], w_ff2[l])
    return rmsnorm(h, final_g)
```

```cpp
#include <hip/hip_runtime.h>
#include <hip/hip_cooperative_groups.h>
#include <cstdio>
#include <cstdint>

namespace cg = cooperative_groups;

#define DI __device__ __forceinline__
#define LAS __attribute__((address_space(3)))
typedef unsigned short bf16_t;
typedef short bf16x8 __attribute__((ext_vector_type(8)));
typedef float f32x4 __attribute__((ext_vector_type(4)));
typedef float f32x2 __attribute__((ext_vector_type(2)));
typedef float f32x16 __attribute__((ext_vector_type(16)));
typedef unsigned u32x4 __attribute__((ext_vector_type(4)));
typedef unsigned u32x2 __attribute__((ext_vector_type(2)));
typedef __bf16 bf16x2_t __attribute__((ext_vector_type(2)));

constexpr int M = 16384, DM = 1024, SEQ = 4096, NB = 4, MEML = 256, DFF = 4096;
constexpr int NPROJ = 3072, PJW = 2304;
constexpr int IN_DIM = 2824;
constexpr float EPS = 1e-5f;

constexpr size_t MiB = 1u << 20;
constexpr size_t WS_W = 1 * MiB;
constexpr size_t WL_IN = 0, WL_OUT = 6 * MiB, WL_XQ = 8 * MiB, WL_XO = 9 * MiB, WL_FF1 = 10 * MiB, WL_FF2 = 18 * MiB, WL_SZ = 26 * MiB;
constexpr size_t WS_WMEM = WS_W + 2 * WL_SZ;
constexpr size_t WS_HB = 57 * MiB;
constexpr size_t WS_XST = WS_HB, WS_BC = WS_HB + 16 * MiB;
constexpr size_t WS_U = 89 * MiB;
constexpr size_t WS_PJ = WS_U, WS_VT = WS_U + 72 * MiB, WS_YALL = WS_U + 88 * MiB, WS_XQ = WS_U, WS_XAO = WS_U + 16 * MiB;
constexpr size_t WS_ST = 217 * MiB;
constexpr size_t WS_MK = 233 * MiB, WS_MVT = 235 * MiB;
constexpr size_t WS_SS = 237 * MiB;
constexpr size_t WS_DT = 238 * MiB, WS_ACUM = WS_DT + MiB / 2, WS_DTRAW = 239 * MiB;
constexpr size_t WS_MEMB = 240 * MiB;
constexpr size_t WS_RMEM = 242 * MiB;
constexpr size_t WS_END = 243 * MiB;

constexpr int LDS_BYTES = 147456;

DI unsigned pk2(float lo, float hi) { f32x2 v = {lo, hi}; bf16x2_t b = __builtin_convertvector(v, bf16x2_t); return __builtin_bit_cast(unsigned, b); }
DI float fexp(float x) { return __builtin_amdgcn_exp2f(x * 1.4426950408889634f); }
DI float flog(float x) { return __builtin_amdgcn_logf(x) * 0.6931471805599453f; }
DI float flog1p(float e) { return e < 1e-2f ? e * (1.f - e * (0.5f - e * 0.33333333f)) : flog(1.f + e); }
DI float bf2f(bf16_t v) { return __uint_as_float((unsigned)v << 16); }
DI bf16_t f2bf(float f) { return (bf16_t)(pk2(f, 0.f) & 0xffffu); }
DI bf16x8 ldg8(const bf16_t* p) { return *(const bf16x8*)p; }
DI int crow(int i, int hi) { return (i & 3) + 8 * (i >> 2) + 4 * hi; }
DI int pi_row(int r) { return 16 * ((r >> 2) & 1) + 4 * (r >> 3) + (r & 3); }
#define MFMA32(a, b, c) __builtin_amdgcn_mfma_f32_32x32x16_bf16((a), (b), (c), 0, 0, 0)
DI bf16x8 pack8(float a0, float a1, float a2, float a3, float a4, float a5, float a6, float a7) {
    u32x4 p; p.x = pk2(a0, a1); p.y = pk2(a2, a3); p.z = pk2(a4, a5); p.w = pk2(a6, a7); return __builtin_bit_cast(bf16x8, p);
}
DI float wave_sum(float v) {
#pragma unroll
    for (int o = 1; o < 64; o <<= 1) v += __shfl_xor(v, o);
    return v;
}
DI float row_rs(const float* SS, int row) {
    const f32x4* p = (const f32x4*)(SS + (size_t)row * 16); const f32x4 a = p[0], b = p[1], c = p[2], d = p[3];
    const float s = ((a.x + a.y) + (a.z + a.w)) + ((b.x + b.y) + (b.z + b.w)) + ((c.x + c.y) + (c.z + c.w)) + ((d.x + d.y) + (d.z + d.w));
    return __builtin_amdgcn_rsqf(s * (1.0f / 1024.0f) + EPS);
}

namespace pg8 {
#define PG8_LAS __attribute__((address_space(3)))
constexpr int BM = 256, BK = 64, HALF = 128, HTB = HALF * BK * 2, STAGE_BYTES = 8 * HTB, NXCD = 8, WGM = 8;
__host__ __device__ __forceinline__ int lds_byte(int r, int c) { const int st = (r >> 4) * 2 + (c >> 5), rr = r & 15, cc = c & 31, ob = rr * 64 + cc * 2; return st * 1024 + (ob ^ (((ob >> 9) & 1) << 5)); }
__host__ __device__ __forceinline__ void stage_rc(int b, int& R, int& C) { const int st = b / 1024, sb = b % 1024, swz = sb ^ (((sb >> 9) & 1) << 5); R = (st >> 1) * 16 + swz / 64; C = (st & 1) * 32 + (swz % 64) / 2; }
__host__ __device__ __forceinline__ int perm32(int rho) { const int n = rho >> 4, i = rho & 15; return 8 * (i >> 2) + 4 * n + (i & 3); }
struct Unit { int pm, pn; };
struct Gemm { const bf16_t* A; const bf16_t* Bt; int M, N, K; };
struct StaticOrder {
    int nM, nN, nwg, G, c;
    __host__ __device__ void init(int M_, int N_, int G_, int c_) { nM = M_ / BM; nN = N_ / BM; nwg = nM * nN; G = G_; c = c_; }
    __host__ __device__ bool next(int i, Unit& u) const {
        const long L = (long)i * G + c; if (L >= nwg) return false;
        int wgid = (int)L; { const int q = nwg / NXCD, r = nwg % NXCD, xcd = wgid % NXCD, off = wgid / NXCD; wgid = (xcd < r ? xcd * (q + 1) : r * (q + 1) + (xcd - r) * q) + off; }
        const int nig = WGM * nN, gid = wgid / nig, fm = gid * WGM, gsz = (nM - fm) < WGM ? (nM - fm) : WGM;
        u.pm = fm + ((wgid % nig) % gsz); u.pn = (wgid % nig) / gsz; return true;
    }
    __device__ __forceinline__ void a_ready(const Unit&) const {}
    __device__ __forceinline__ void done(const Unit&) const {}
};

template <class Epi, class Sched, bool ALIGN_EPI = false, bool SP2 = false>
__device__ __forceinline__ void gemm_phase(PG8_LAS unsigned char* lds, const Gemm g, const Sched& S, const Epi& E, const int tid) {
    const int wid = __builtin_amdgcn_readfirstlane(tid >> 6), lane = tid & 63, wr = wid >> 2, wc = wid & 3, fr = lane & 15, fq = lane >> 4;
    const int K = g.K, nt = K / BK;
    unsigned voffA[2], voffB[2];
#pragma unroll
    for (int i = 0; i < 2; ++i) { int R, C; stage_rc(tid * 16 + i * 8192, R, C); const int Rb = Epi::PERM ? ((R & ~31) + perm32(R & 31)) : R;
        voffA[i] = (unsigned)(R * K + C) * 2u; voffB[i] = (unsigned)(Rb * K + C) * 2u; }
    const size_t kstep = (size_t)(BK * 2);
    const size_t hstep = (size_t)HALF * K * 2;
    const size_t tstep = 2 * hstep;
    const unsigned ldsw = (unsigned)wid * 1024u;
    const int aoff = lds_byte(wr * 64 + fr, fq * 8), boff = lds_byte(wc * 32 + fr, fq * 8);
#define PG8_SA(b, h) (((b) * 2 + (h)) * HTB)
#define PG8_SB(b, h) ((4 + (b) * 2 + (h)) * HTB)
#define PG8_STAGE(bufoff, gbase, voff) do { _Pragma("unroll") for (int _i = 0; _i < 2; ++_i) \
        __builtin_amdgcn_global_load_lds((const unsigned*)((const char*)(gbase) + (voff)[_i]), (PG8_LAS unsigned*)(lds + (bufoff) + ldsw + _i * 8192), 16, 0, 0); } while (0)
#define PG8_LDA(dst, b, h) do { _Pragma("unroll") for (int m = 0; m < 4; ++m) _Pragma("unroll") for (int k = 0; k < 2; ++k) dst[m][k] = *(const PG8_LAS bf16x8*)(lds + PG8_SA(b, h) + aoff + m * 2048 + k * 1024); } while (0)
#define PG8_LDB(dst, b, h) do { _Pragma("unroll") for (int n = 0; n < 2; ++n) _Pragma("unroll") for (int k = 0; k < 2; ++k) dst[n][k] = *(const PG8_LAS bf16x8*)(lds + PG8_SB(b, h) + boff + n * 2048 + k * 1024); } while (0)
#define PG8_MMA(ai, bj, At, Bt) do { __builtin_amdgcn_s_setprio(1); _Pragma("unroll") for (int m = 0; m < 4; ++m) _Pragma("unroll") for (int n = 0; n < 2; ++n) _Pragma("unroll") for (int k = 0; k < 2; ++k) \
        acc[ai][bj][m][n] = __builtin_amdgcn_mfma_f32_16x16x32_bf16(Bt[n][k], At[m][k], acc[ai][bj][m][n], 0, 0, 0); __builtin_amdgcn_s_setprio(0); } while (0)
#define PG8_WAIT_V(n) asm volatile("s_waitcnt vmcnt(" #n ")" ::: "memory")
#define PG8_WAIT_L(n) asm volatile("s_waitcnt lgkmcnt(" #n ")" ::: "memory")
#define PG8_BAR __builtin_amdgcn_s_barrier()
#define PG8_SCHED __builtin_amdgcn_sched_barrier(0)
    Unit cur, nxt; int ui = 0;
    if (!S.next(0, cur)) return;
    f32x4 acc[2][2][4][2];
#pragma unroll
    for (int a = 0; a < 2; ++a)
#pragma unroll
        for (int b = 0; b < 2; ++b)
#pragma unroll
            for (int m = 0; m < 4; ++m)
#pragma unroll
                for (int n = 0; n < 2; ++n) acc[a][b][m][n] = (f32x4){0.f, 0.f, 0.f, 0.f};
    bf16x8 At[4][2], B0[2][2], B1[2][2];
    const char* cA = (const char*)g.A + (size_t)cur.pm * tstep; const char* cB = (const char*)g.Bt + (size_t)cur.pn * tstep;
    S.a_ready(cur);
    if constexpr (SP2) {
        PG8_STAGE(PG8_SB(0, 0), cB, voffB); PG8_STAGE(PG8_SB(0, 1), cB + hstep, voffB); PG8_STAGE(PG8_SA(0, 0), cA, voffA); PG8_STAGE(PG8_SA(0, 1), cA + hstep, voffA);
        if (wr == 1) PG8_BAR;
        PG8_WAIT_V(2); PG8_BAR;
        PG8_STAGE(PG8_SB(1, 0), cB + kstep, voffB); PG8_STAGE(PG8_SA(1, 0), cA + kstep, voffA); PG8_STAGE(PG8_SB(1, 1), cB + hstep + kstep, voffB);
        PG8_WAIT_V(6); PG8_BAR;
    } else {
        PG8_STAGE(PG8_SB(0, 0), cB, voffB); PG8_STAGE(PG8_SA(0, 0), cA, voffA); PG8_STAGE(PG8_SB(0, 1), cB + hstep, voffB); PG8_STAGE(PG8_SA(0, 1), cA + hstep, voffA);
        if (wr == 1) PG8_BAR;
        PG8_WAIT_V(4); PG8_BAR;
        PG8_STAGE(PG8_SB(1, 0), cB + kstep, voffB); PG8_STAGE(PG8_SA(1, 0), cA + kstep, voffA); PG8_STAGE(PG8_SB(1, 1), cB + hstep + kstep, voffB);
        PG8_WAIT_V(6); PG8_BAR;
    }
    for (;;) {
        const bool has_next = S.next(ui + 1, nxt);
        const char* nA = has_next ? (const char*)g.A + (size_t)nxt.pm * tstep : cA; const char* nB = has_next ? (const char*)g.Bt + (size_t)nxt.pn * tstep : cB;
        for (int t = 0; t < nt; t += 2) {
            const bool last = (t == nt - 2);
            const char* a1 = cA + (size_t)(t + 1) * kstep;
            const char* a2 = last ? nA : cA + (size_t)(t + 2) * kstep; const char* b2 = last ? nB : cB + (size_t)(t + 2) * kstep;
            const char* a3 = a2 + kstep; const char* b3 = b2 + kstep;
            if (last && has_next) S.a_ready(nxt);
            if constexpr (SP2) {
            PG8_LDB(B0, 0, 0); PG8_LDB(B1, 0, 1); PG8_SCHED; PG8_LDA(At, 0, 0); PG8_STAGE(PG8_SA(1, 1), a1 + hstep, voffA);
            PG8_WAIT_V(8); PG8_WAIT_L(0); PG8_BAR; PG8_MMA(0, 0, At, B0); PG8_MMA(0, 1, At, B1); PG8_BAR; PG8_SCHED;
            PG8_LDA(At, 0, 1); PG8_STAGE(PG8_SB(0, 0), b2, voffB); PG8_STAGE(PG8_SB(0, 1), b2 + hstep, voffB); PG8_STAGE(PG8_SA(0, 0), a2, voffA);
            PG8_WAIT_V(8); PG8_WAIT_L(0); PG8_BAR; PG8_MMA(1, 0, At, B0); PG8_MMA(1, 1, At, B1); PG8_BAR; PG8_SCHED;
            PG8_LDB(B0, 1, 0); PG8_LDB(B1, 1, 1); PG8_SCHED; PG8_LDA(At, 1, 0); PG8_STAGE(PG8_SA(0, 1), a2 + hstep, voffA);
            PG8_WAIT_V(8); PG8_WAIT_L(0); PG8_BAR; PG8_MMA(0, 0, At, B0); PG8_MMA(0, 1, At, B1); PG8_BAR; PG8_SCHED;
            PG8_LDA(At, 1, 1); PG8_STAGE(PG8_SB(1, 0), b3, voffB); PG8_STAGE(PG8_SB(1, 1), b3 + hstep, voffB); PG8_STAGE(PG8_SA(1, 0), a3, voffA);
            PG8_WAIT_V(8); PG8_WAIT_L(0); PG8_BAR; PG8_MMA(1, 0, At, B0); PG8_MMA(1, 1, At, B1); PG8_BAR; PG8_SCHED;
            } else {
            PG8_LDB(B0, 0, 0); PG8_SCHED; PG8_LDA(At, 0, 0); PG8_STAGE(PG8_SA(1, 1), a1 + hstep, voffA);
            PG8_WAIT_L(8); PG8_BAR; PG8_WAIT_L(0); PG8_MMA(0, 0, At, B0); PG8_BAR; PG8_SCHED;
            PG8_LDB(B1, 0, 1); PG8_STAGE(PG8_SB(0, 0), b2, voffB);
            PG8_BAR; PG8_WAIT_L(0); PG8_MMA(0, 1, At, B1); PG8_BAR;
            PG8_LDA(At, 0, 1); PG8_STAGE(PG8_SA(0, 0), a2, voffA);
            PG8_BAR; PG8_WAIT_L(0); PG8_MMA(1, 0, At, B0); PG8_BAR; PG8_SCHED;
            PG8_STAGE(PG8_SB(0, 1), b2 + hstep, voffB);
            PG8_WAIT_V(6); PG8_BAR; PG8_MMA(1, 1, At, B1); PG8_BAR;
            PG8_LDB(B0, 1, 0); PG8_SCHED; PG8_LDA(At, 1, 0); PG8_STAGE(PG8_SA(0, 1), a2 + hstep, voffA);
            PG8_WAIT_L(8); PG8_BAR; PG8_WAIT_L(0); PG8_MMA(0, 0, At, B0); PG8_BAR; PG8_SCHED;
            PG8_LDB(B1, 1, 1); PG8_STAGE(PG8_SB(1, 0), b3, voffB);
            PG8_BAR; PG8_WAIT_L(0); PG8_MMA(0, 1, At, B1); PG8_BAR;
            PG8_LDA(At, 1, 1); PG8_STAGE(PG8_SA(1, 0), a3, voffA);
            PG8_BAR; PG8_WAIT_L(0); PG8_MMA(1, 0, At, B0); PG8_BAR; PG8_SCHED;
            PG8_STAGE(PG8_SB(1, 1), b3 + hstep, voffB);
            PG8_WAIT_V(6); PG8_BAR; PG8_MMA(1, 1, At, B1); PG8_BAR;
            }
        }
        if constexpr (ALIGN_EPI) { if (wr == 0) PG8_BAR; }
        E(acc, cur, wr, wc, fr, fq); S.done(cur);
        if (!has_next) break;
#pragma unroll
        for (int a = 0; a < 2; ++a)
#pragma unroll
            for (int b = 0; b < 2; ++b)
#pragma unroll
                for (int m = 0; m < 4; ++m)
#pragma unroll
                    for (int n = 0; n < 2; ++n) acc[a][b][m][n] = (f32x4){0.f, 0.f, 0.f, 0.f};
        cur = nxt; cA = nA; cB = nB; ++ui;
        if constexpr (ALIGN_EPI) { if (wr == 1) PG8_BAR; }
    }
    PG8_WAIT_V(0);
    if constexpr (!ALIGN_EPI) { if (wr == 0) PG8_BAR; }
    PG8_BAR;
#undef PG8_SA
#undef PG8_SB
#undef PG8_STAGE
#undef PG8_LDA
#undef PG8_LDB
#undef PG8_MMA
#undef PG8_WAIT_V
#undef PG8_WAIT_L
#undef PG8_BAR
#undef PG8_SCHED
}
}
using pg8::Unit;

DI void st8(bf16_t* p, f32x4 v0, f32x4 v1) { u32x4 w; w.x = pk2(v0[0], v0[1]); w.y = pk2(v0[2], v0[3]); w.z = pk2(v1[0], v1[1]); w.w = pk2(v1[2], v1[3]); *(u32x4*)p = w; }

struct EpiProj {
    static constexpr bool PERM = true;
    bf16_t* PJ; bf16_t* VT; float* DTRAW; const float* SS;
    DI void operator()(const f32x4 (&acc)[2][2][4][2], const Unit& u, int wr, int wc, int fr, int fq) const {
        const int row0 = u.pm * 256 + wr * 64 + fr;
#pragma unroll
        for (int ai = 0; ai < 2; ++ai)
#pragma unroll
            for (int m = 0; m < 4; ++m) {
                const int row = row0 + ai * 128 + m * 16; const float rs = row_rs(SS, row);
#pragma unroll
                for (int bj = 0; bj < 2; ++bj) {
                    const f32x4 v0 = acc[ai][bj][m][0] * rs, v1 = acc[ai][bj][m][1] * rs; const int col = u.pn * 256 + bj * 128 + wc * 32 + 8 * fq;
                    if (u.pn < 9) st8(PJ + (size_t)row * PJW + col, v0, v1);
                    else if (u.pn < 11) { const int cp = col - 2304, head = cp >> 6, d = cp & 63, b = row >> 12, t = row & 4095;
                        bf16_t* base = VT + ((size_t)((b * 8 + head) * 64 + d)) * 4096 + t;
                        base[0 * 4096] = f2bf(v0[0]); base[1 * 4096] = f2bf(v0[1]); base[2 * 4096] = f2bf(v0[2]); base[3 * 4096] = f2bf(v0[3]);
                        base[4 * 4096] = f2bf(v1[0]); base[5 * 4096] = f2bf(v1[1]); base[6 * 4096] = f2bf(v1[2]); base[7 * 4096] = f2bf(v1[3]); }
                    else if (bj == 0 && wc == 0 && fq == 0) { *(f32x4*)(DTRAW + (size_t)row * 8) = v0; *(f32x4*)(DTRAW + (size_t)row * 8 + 4) = v1; }
                }
            }
    }
};
struct EpiResid {
    static constexpr bool PERM = false;
    const float* base; float* out; bf16_t* HB; float* SS;
    DI void operator()(const f32x4 (&acc)[2][2][4][2], const Unit& u, int wr, int wc, int fr, int fq) const {
        const int row0 = u.pm * 256 + wr * 64 + fr, col0 = u.pn * 256 + wc * 32 + 4 * fq;
#pragma unroll
        for (int ai = 0; ai < 2; ++ai)
#pragma unroll
            for (int m = 0; m < 4; ++m) {
                const int row = row0 + ai * 128 + m * 16; const size_t off = (size_t)row * DM + col0; float s = 0.f;
#pragma unroll
                for (int bj = 0; bj < 2; ++bj)
#pragma unroll
                    for (int n = 0; n < 2; ++n) {
                        const size_t o = off + bj * 128 + n * 16; const f32x4 v = *(const f32x4*)(base + o) + acc[ai][bj][m][n];
                        *(f32x4*)(out + o) = v; u32x2 w; w.x = pk2(v[0], v[1]); w.y = pk2(v[2], v[3]); *(u32x2*)(HB + o) = w;
                        s += (v[0] * v[0] + v[1] * v[1]) + (v[2] * v[2] + v[3] * v[3]);
                    }
                s += __shfl_xor(s, 16); s += __shfl_xor(s, 32);
                if (fq == 0) SS[(size_t)row * 16 + u.pn * 4 + wc] = s;
            }
    }
};
template <int ACT> struct EpiScale {
    static constexpr bool PERM = true;
    bf16_t* O; int ldc; const float* SS; float scale;
    DI void operator()(const f32x4 (&acc)[2][2][4][2], const Unit& u, int wr, int wc, int fr, int fq) const {
        const int row0 = u.pm * 256 + wr * 64 + fr;
#pragma unroll
        for (int ai = 0; ai < 2; ++ai)
#pragma unroll
            for (int m = 0; m < 4; ++m) {
                const int row = row0 + ai * 128 + m * 16; const float rs = row_rs(SS, row) * scale;
#pragma unroll
                for (int bj = 0; bj < 2; ++bj) {
                    f32x4 v0 = acc[ai][bj][m][0] * rs, v1 = acc[ai][bj][m][1] * rs;
                    if (ACT == 1) {
#pragma unroll
                        for (int e = 0; e < 4; ++e) { const float a = __builtin_fmaxf(v0[e], 0.f), b = __builtin_fmaxf(v1[e], 0.f); v0[e] = a * a; v1[e] = b * b; }
                    }
                    st8(O + (size_t)row * ldc + u.pn * 256 + bj * 128 + wc * 32 + 8 * fq, v0, v1);
                }
            }
    }
};
struct EpiMem {
    static constexpr bool PERM = true;
    bf16_t* MK; bf16_t* MVT; const float* RMEM;
    DI void operator()(const f32x4 (&acc)[2][2][4][2], const Unit& u, int wr, int wc, int fr, int fq) const {
        const int row0 = u.pm * 256 + wr * 64 + fr;
#pragma unroll
        for (int ai = 0; ai < 2; ++ai)
#pragma unroll
            for (int m = 0; m < 4; ++m) {
                const int row = row0 + ai * 128 + m * 16; const float rs = RMEM[row]; const int b = row >> 8, mm = row & 255;
#pragma unroll
                for (int bj = 0; bj < 2; ++bj) {
                    const f32x4 v0 = acc[ai][bj][m][0] * rs, v1 = acc[ai][bj][m][1] * rs; const int c = u.pn * 256 + bj * 128 + wc * 32 + 8 * fq;
                    const int layer = c >> 10, kv = (c >> 9) & 1, head = (c >> 7) & 3, d = c & 127;
                    if (kv == 0) st8(MK + ((size_t)(((layer * 4 + b) * 4 + head) * 256 + mm)) * 128 + d, v0, v1);
                    else { bf16_t* p = MVT + ((size_t)(((layer * 4 + b) * 4 + head) * 128 + d)) * 256 + mm;
                        p[0 * 256] = f2bf(v0[0]); p[1 * 256] = f2bf(v0[1]); p[2 * 256] = f2bf(v0[2]); p[3 * 256] = f2bf(v0[3]);
                        p[4 * 256] = f2bf(v1[0]); p[5 * 256] = f2bf(v1[1]); p[6 * 256] = f2bf(v1[2]); p[7 * 256] = f2bf(v1[3]); }
                }
            }
    }
};

struct Params {
    const float* x; const float* mem; const float* norm_mix_g; const float* w_in; const float* conv_w; const float* conv_b; const float* dt_bias; const float* a_log;
    const float* d_skip; const float* ssd_norm_g; const float* sb_norm_g; const float* w_out; const float* norm_xa_g; const float* norm_mem_g;
    const float* w_xq; const float* w_xk; const float* w_xv; const float* w_xo; const float* norm_ff_g; const float* w_ff1; const float* w_ff2; const float* final_g;
    float* out; unsigned char* ws; int ph_lo, ph_hi;
};

#define LDS_WAIT() asm volatile("s_waitcnt lgkmcnt(0)" ::: "memory")

DI void transpose_item(const float* __restrict__ W, int K, int N, bf16_t* WT, const float* g, const float* g2, int gsplit, int mode, LAS float* scr, int item, int lane) {
    const int nblk = (N + 31) / 32, kb = item / nblk, nb = item % nblk, k0 = 64 * kb, n0 = 32 * nb;
    const int n = n0 + (lane & 31);
#pragma unroll 8
    for (int i = 0; i < 32; ++i) { const int kk = 2 * i + (lane >> 5), kg = k0 + kk; float v = 0.f;
        if (n < N) { v = W[(size_t)kg * N + n]; if (mode != 2) v *= (kg < gsplit ? g[kg] : g2[kg - gsplit]); }
        scr[kk * 33 + (lane & 31)] = v; }
    LDS_WAIT();
    const int c = lane & 7;
#pragma unroll
    for (int j = 0; j < 4; ++j) { const int nl = (lane >> 3) + 8 * j, nn = n0 + nl;
        if (nn < N) { int dr = nn; if (mode == 1) dr = (nn < 1280) ? nn : (nn < 1288 ? 2816 + (nn - 1280) : nn - 8);
            const LAS float* s = scr + (8 * c) * 33 + nl;
            u32x4 o; o.x = pk2(s[0 * 33], s[1 * 33]); o.y = pk2(s[2 * 33], s[3 * 33]); o.z = pk2(s[4 * 33], s[5 * 33]); o.w = pk2(s[6 * 33], s[7 * 33]);
            *(u32x4*)(WT + (size_t)dr * K + k0 + 8 * c) = o; } }
    LDS_WAIT();
}
DI float row_to_bf16(const float* xrow, bf16_t* orow, int lane) {
    const f32x4* xr = (const f32x4*)xrow + lane; f32x4 v[4]; float s = 0.f;
#pragma unroll
    for (int j = 0; j < 4; ++j) { v[j] = xr[64 * j]; s += (v[j].x * v[j].x + v[j].y * v[j].y) + (v[j].z * v[j].z + v[j].w * v[j].w); }
    u32x2* o8 = (u32x2*)orow + lane;
#pragma unroll
    for (int j = 0; j < 4; ++j) { u32x2 w; w.x = pk2(v[j].x, v[j].y); w.y = pk2(v[j].z, v[j].w); o8[64 * j] = w; }
    return wave_sum(s);
}

__global__ void __launch_bounds__(512, 2) fwd_kernel(Params P) {
    extern __shared__ __attribute__((aligned(16))) unsigned char lds_raw[];
    LAS unsigned char* lds = (LAS unsigned char*)lds_raw;
    cg::grid_group grid = cg::this_grid();
    const int lo = P.ph_lo, hi_ph = P.ph_hi;
    int ph = 0;
    int layer = 0;
#define PHASE_BEGIN if (ph >= lo && ph < hi_ph) { \
    int tid = threadIdx.x; asm volatile("" : "+v"(tid)); int bx = blockIdx.x; asm volatile("" : "+s"(bx)); unsigned char* ws = P.ws; asm volatile("" : "+s"(ws)); \
    const int lane = tid & 63, wave = __builtin_amdgcn_readfirstlane(tid >> 6), G = gridDim.x, vcu = (G % 8 == 0) ? (bx % 8) * (G / 8) + bx / 8 : bx, r = lane & 31, hi = lane >> 5; \
    bf16_t* HB = (bf16_t*)(ws + WS_HB); bf16_t* XST = (bf16_t*)(ws + WS_XST); bf16_t* BC = (bf16_t*)(ws + WS_BC); \
    bf16_t* U = (bf16_t*)(ws + WS_U); bf16_t* PJ = (bf16_t*)(ws + WS_PJ); bf16_t* VT = (bf16_t*)(ws + WS_VT); bf16_t* YALL = (bf16_t*)(ws + WS_YALL); \
    bf16_t* XQ = (bf16_t*)(ws + WS_XQ); bf16_t* XAO = (bf16_t*)(ws + WS_XAO); \
    float* ST = (float*)(ws + WS_ST); bf16_t* MK = (bf16_t*)(ws + WS_MK); bf16_t* MVT = (bf16_t*)(ws + WS_MVT); \
    float* SS = (float*)(ws + WS_SS); float* DT = (float*)(ws + WS_DT); float* ACUM = (float*)(ws + WS_ACUM); float* DTRAW = (float*)(ws + WS_DTRAW); \
    bf16_t* MEMB = (bf16_t*)(ws + WS_MEMB); float* RMEM = (float*)(ws + WS_RMEM); bf16_t* WMEM = (bf16_t*)(ws + WS_WMEM); \
    unsigned char* wl = ws + WS_W + (size_t)layer * WL_SZ; \
    (void)lane; (void)wave; (void)vcu; (void)r; (void)hi; (void)HB; (void)XST; (void)BC; (void)U; (void)PJ; (void)VT; (void)YALL; (void)XQ; (void)XAO; (void)ST; (void)MK; (void)MVT; \
    (void)SS; (void)DT; (void)ACUM; (void)DTRAW; (void)MEMB; (void)RMEM; (void)WMEM; (void)wl;
#define PHASE_END   if (ph + 1 < hi_ph) grid.sync(); } ++ph;

    PHASE_BEGIN
    {
        LAS float* scr = (LAS float*)(lds + wave * 16384);
        const int gw = vcu * 8 + wave, NGW = G * 8;
        constexpr int I_IN = 16 * 89, I_OUT = 16 * 32, I_XQ = 16 * 16, I_XO = 8 * 32, I_F1 = 16 * 128, I_F2 = 64 * 32, I_L = I_IN + I_OUT + 3 * I_XQ + I_XO + I_F1 + I_F2;
        for (int it = gw; it < 2 * I_L; it += NGW) {
            const int l = it / I_L; int q = it % I_L; unsigned char* wl = ws + WS_W + (size_t)l * WL_SZ;
            const float* W; int K = DM, N; bf16_t* WT; const float* g1 = P.final_g; const float* g2 = P.final_g; int gsplit = 1 << 30, mode = 0;
            if (q < I_IN) { W = P.w_in + (size_t)l * DM * IN_DIM; N = IN_DIM; WT = (bf16_t*)(wl + WL_IN); g1 = P.norm_mix_g + l * DM; mode = 1; }
            else if ((q -= I_IN) < I_OUT) { W = P.w_out + (size_t)l * DM * DM; N = DM; WT = (bf16_t*)(wl + WL_OUT); g1 = P.ssd_norm_g + l * 512; g2 = P.sb_norm_g + l * 512; gsplit = 512; }
            else if ((q -= I_OUT) < I_XQ) { W = P.w_xq + (size_t)l * DM * 512; N = 512; WT = (bf16_t*)(wl + WL_XQ); g1 = P.norm_xa_g + l * DM; }
            else if ((q -= I_XQ) < I_XQ) { W = P.w_xk + (size_t)l * DM * 512; N = 512; WT = WMEM + (size_t)(l * 1024) * DM; g1 = P.norm_mem_g + l * DM; }
            else if ((q -= I_XQ) < I_XQ) { W = P.w_xv + (size_t)l * DM * 512; N = 512; WT = WMEM + (size_t)(l * 1024 + 512) * DM; g1 = P.norm_mem_g + l * DM; }
            else if ((q -= I_XQ) < I_XO) { W = P.w_xo + (size_t)l * 512 * DM; K = 512; N = DM; WT = (bf16_t*)(wl + WL_XO); mode = 2; }
            else if ((q -= I_XO) < I_F1) { W = P.w_ff1 + (size_t)l * DM * DFF; N = DFF; WT = (bf16_t*)(wl + WL_FF1); g1 = P.norm_ff_g + l * DM; }
            else { q -= I_F1; W = P.w_ff2 + (size_t)l * DFF * DM; K = DFF; N = DM; WT = (bf16_t*)(wl + WL_FF2); mode = 2; }
            transpose_item(W, K, N, WT, g1, g2, gsplit, mode, scr, q, lane);
        }
        for (int i = bx * 512 + tid; i < 2 * 248 * 128; i += G * 512) { const int l = i / (248 * 128), q = i % (248 * 128);
            *(u32x4*)((bf16_t*)(ws + WS_W + (size_t)l * WL_SZ + WL_IN) + (size_t)(2824 + q / 128) * DM + (q % 128) * 8) = (u32x4){0u, 0u, 0u, 0u}; }
        for (int m = gw; m < M; m += NGW) { const float s = row_to_bf16(P.x + (size_t)m * DM, HB + (size_t)m * DM, lane);
            if (lane < 16) SS[(size_t)m * 16 + lane] = (lane == 0) ? s : 0.f; }
        for (int m = gw; m < NB * MEML; m += NGW) { const float s = row_to_bf16(P.mem + (size_t)m * DM, MEMB + (size_t)m * DM, lane);
            if (lane == 0) RMEM[m] = __builtin_amdgcn_rsqf(s * (1.0f / 1024.0f) + EPS); }
    }
    PHASE_END

    PHASE_BEGIN
    {
        pg8::Gemm g{MEMB, WMEM, NB * MEML, 2048, DM}; pg8::StaticOrder S; S.init(NB * MEML, 2048, G, bx);
        EpiMem E{MK, MVT, RMEM};
        pg8::gemm_phase<EpiMem, pg8::StaticOrder, true, true>(lds, g, S, E, tid);
    }
    PHASE_END

    for (layer = 0; layer < 2; ++layer) {
        PHASE_BEGIN
        {
            pg8::Gemm g{HB, (const bf16_t*)(wl + WL_IN), M, NPROJ, DM}; pg8::StaticOrder S; S.init(M, NPROJ, G, bx);
            EpiProj E{PJ, VT, DTRAW, SS};
            pg8::gemm_phase<EpiProj, pg8::StaticOrder, true, true>(lds, g, S, E, tid);
        }
        PHASE_END

        PHASE_BEGIN
        {
            LAS float* scl = (LAS float*)lds;
            LAS bf16_t* XT = (LAS bf16_t*)(lds + 4096);
            constexpr int LP = 136;
            for (int u = vcu; u < 256; u += G) {
                const int b = u >> 6, c = (u >> 1) & 31, g = u & 1; const size_t rowc = (size_t)b * SEQ + c * 128;
                if (wave < 4) {
                    const int h = 4 * g + wave, t0 = 2 * lane;
                    const float dtb = P.dt_bias[layer * 8 + h], A = -fexp(P.a_log[layer * 8 + h]);
                    const float x0 = DTRAW[(rowc + t0) * 8 + h] + dtb, x1 = DTRAW[(rowc + t0 + 1) * 8 + h] + dtb;
                    const float d0 = __builtin_fmaxf(x0, 0.f) + flog1p(fexp(-__builtin_fabsf(x0))), d1 = __builtin_fmaxf(x1, 0.f) + flog1p(fexp(-__builtin_fabsf(x1)));
                    const float a0 = d0 * A, a1 = d1 * A, pair = a0 + a1; float incl = pair;
#pragma unroll
                    for (int o = 1; o < 64; o <<= 1) { const float t = __shfl_up(incl, o); if (lane >= o) incl += t; }
                    const float excl = incl - pair, ac0 = excl + a0, ac1 = incl, last = __shfl(incl, 63);
                    DT[(rowc + t0) * 8 + h] = d0; DT[(rowc + t0 + 1) * 8 + h] = d1; ACUM[(rowc + t0) * 8 + h] = ac0; ACUM[(rowc + t0 + 1) * 8 + h] = ac1;
                    scl[wave * 128 + t0] = d0 * fexp(last - ac0); scl[wave * 128 + t0 + 1] = d1 * fexp(last - ac1);
                }
                __syncthreads();
                for (int it = tid; it < 48 * 16; it += 512) {
                    const int cgp = it % 48, l0 = (it / 48) * 8;
                    const int pjcol = cgp < 32 ? 512 + g * 256 + cgp * 8 : (cgp < 40 ? 1024 + g * 64 + (cgp - 32) * 8 : 1152 + g * 64 + (cgp - 40) * 8);
                    const int cc = pjcol - 512;
                    u32x4 raw[11];
#pragma unroll
                    for (int j = 0; j < 11; ++j) { const int pos = c * 128 + l0 - 3 + j;
                        raw[j] = pos >= 0 ? *(const u32x4*)(PJ + (size_t)(rowc + l0 - 3 + j) * PJW + pjcol) : (u32x4){0u, 0u, 0u, 0u}; }
                    const float* cw = P.conv_w + (size_t)layer * 4 * 768 + cc; const float* cbp = P.conv_b + (size_t)layer * 768 + cc;
                    float o[8][8];
#pragma unroll
                    for (int j8 = 0; j8 < 8; ++j8) {
                        const float w0 = cw[j8], w1 = cw[768 + j8], w2 = cw[2 * 768 + j8], w3 = cw[3 * 768 + j8], bb = cbp[j8];
                        float xv[11];
#pragma unroll
                        for (int j = 0; j < 11; ++j) { const unsigned wd = raw[j][j8 >> 1]; xv[j] = __uint_as_float((j8 & 1) ? (wd & 0xffff0000u) : (wd << 16)); }
#pragma unroll
                        for (int t = 0; t < 8; ++t) { const float v = bb + w0 * xv[t] + w1 * xv[t + 1] + w2 * xv[t + 2] + w3 * xv[t + 3]; o[j8][t] = v / (1.f + fexp(-v)); }
                    }
                    if (cgp < 32) {
#pragma unroll
                        for (int j8 = 0; j8 < 8; ++j8) { const int chl = cgp * 8 + j8, e = chl >> 6, p = chl & 63, h = 4 * g + e;
                            *(bf16x8*)(XST + ((size_t)((b * 8 + h) * 64 + p)) * SEQ + c * 128 + l0) = pack8(o[j8][0], o[j8][1], o[j8][2], o[j8][3], o[j8][4], o[j8][5], o[j8][6], o[j8][7]);
                            const LAS float* sc = scl + e * 128 + l0;
                            *(LAS bf16x8*)(XT + chl * LP + l0) = pack8(o[j8][0] * sc[0], o[j8][1] * sc[1], o[j8][2] * sc[2], o[j8][3] * sc[3], o[j8][4] * sc[4], o[j8][5] * sc[5], o[j8][6] * sc[6], o[j8][7] * sc[7]); }
                    } else {
                        const int bccol = cgp < 40 ? g * 64 + (cgp - 32) * 8 : 128 + g * 64 + (cgp - 40) * 8;
#pragma unroll
                        for (int t = 0; t < 8; ++t) *(bf16x8*)(BC + (size_t)(rowc + l0 + t) * 256 + bccol) = pack8(o[0][t], o[1][t], o[2][t], o[3][t], o[4][t], o[5][t], o[6][t], o[7][t]);
                        if (cgp < 40) {
#pragma unroll
                            for (int j8 = 0; j8 < 8; ++j8) *(LAS bf16x8*)(XT + (256 + (cgp - 32) * 8 + j8) * LP + l0) = pack8(o[j8][0], o[j8][1], o[j8][2], o[j8][3], o[j8][4], o[j8][5], o[j8][6], o[j8][7]);
                        }
                    }
                }
                __syncthreads();
                {
                    const int e = wave >> 1, phf = wave & 1, h = 4 * g + e;
                    f32x16 a0 = {}, a1 = {};
#pragma unroll
                    for (int s = 0; s < 8; ++s) {
                        const bf16x8 af = *(const LAS bf16x8*)(XT + (e * 64 + phf * 32 + r) * LP + 16 * s + 8 * hi);
                        const bf16x8 b0 = *(const LAS bf16x8*)(XT + (256 + r) * LP + 16 * s + 8 * hi);
                        const bf16x8 b1 = *(const LAS bf16x8*)(XT + (256 + 32 + r) * LP + 16 * s + 8 * hi);
                        a0 = MFMA32(af, b0, a0); a1 = MFMA32(af, b1, a1);
                    }
                    float* dst = ST + ((size_t)((b * 32 + c) * 8 + h)) * 4096;
#pragma unroll
                    for (int i = 0; i < 16; ++i) { const int p = phf * 32 + crow(i, hi); dst[p * 64 + r] = a0[i]; dst[p * 64 + 32 + r] = a1[i]; }
                }
                __syncthreads();
            }
        }
        PHASE_END

        PHASE_BEGIN
        {
            for (int e = bx * 512 + tid; e < NB * 8 * 4096; e += G * 512) {
                const int b = e >> 15, h = (e >> 12) & 7, pn = e & 4095; float run = 0.f;
                for (int c0 = 0; c0 < 32; c0 += 8) {
                    float s[8], dec[8];
#pragma unroll
                    for (int j = 0; j < 8; ++j) { s[j] = ST[((size_t)((b * 32 + c0 + j) * 8 + h)) * 4096 + pn]; dec[j] = ACUM[((size_t)b * SEQ + (c0 + j) * 128 + 127) * 8 + h]; }
#pragma unroll
                    for (int j = 0; j < 8; ++j) { ST[((size_t)((b * 32 + c0 + j) * 8 + h)) * 4096 + pn] = run; run = run * fexp(dec[j]) + s[j]; }
                }
            }
            LAS float* part = (LAS float*)lds;
            const int h = wave;
            for (int u = vcu; u < 512; u += G) {
                const int b = u >> 7, qb = 127 - (u & 127); const size_t rowbase = (size_t)b * SEQ; const int q0 = qb * 32;
                bf16x8 qf[4];
#pragma unroll
                for (int s = 0; s < 4; ++s) qf[s] = ldg8(PJ + (rowbase + q0 + r) * PJW + 1280 + h * 64 + 16 * s + 8 * hi);
                f32x16 o0 = {}, o1 = {}; float R = 0.f;
                const bf16_t* Kb = PJ + rowbase * PJW + 1792 + h * 64 + 8 * hi;
                const bf16_t* Vb = VT + ((size_t)((b * 8 + h) * 64 + r)) * SEQ + 16 * hi;
                for (int kt = qb; kt >= 0; --kt) {
                    const int key = kt * 32 + pi_row(r);
                    bf16x8 kf[4], vf[2][2];
#pragma unroll
                    for (int s = 0; s < 4; ++s) kf[s] = ldg8(Kb + (size_t)key * PJW + 16 * s);
#pragma unroll
                    for (int d = 0; d < 2; ++d)
#pragma unroll
                        for (int j = 0; j < 2; ++j) vf[d][j] = ldg8(Vb + (size_t)d * 32 * SEQ + kt * 32 + 8 * j);
                    f32x16 st = {};
#pragma unroll
                    for (int s = 0; s < 4; ++s) st = MFMA32(kf[s], qf[s], st);
                    float w[16]; float suf = 0.f;
                    const bool diag = (kt == qb);
#pragma unroll
                    for (int i = 15; i >= 0; --i) {
                        const float z = st[i] * 0.125f; const float sp = __builtin_fmaxf(z, 0.f) + flog(1.f + fexp(-__builtin_fabsf(z)));
                        float ls = -sp, lb = z - sp;
                        if (diag && (16 * hi + i >= r)) { ls = 0.f; lb = -INFINITY; }
                        w[i] = lb + suf; suf += ls;
                    }
                    const float other = __shfl_xor(suf, 32);
                    const float add = R + (hi == 0 ? other : 0.f);
#pragma unroll
                    for (int i = 0; i < 16; ++i) w[i] = fexp(w[i] + add);
                    R += suf + other;
                    const bf16x8 pa0 = pack8(w[0], w[1], w[2], w[3], w[4], w[5], w[6], w[7]), pa1 = pack8(w[8], w[9], w[10], w[11], w[12], w[13], w[14], w[15]);
                    o0 = MFMA32(pa0, vf[0][0], o0); o0 = MFMA32(pa1, vf[0][1], o0); o1 = MFMA32(pa0, vf[1][0], o1); o1 = MFMA32(pa1, vf[1][1], o1);
                    if (__all(R < -110.f)) break;
                }
                float ssq[16];
#pragma unroll
                for (int i = 0; i < 16; ++i) ssq[i] = o0[i] * o0[i] + o1[i] * o1[i];
#pragma unroll
                for (int o = 1; o < 32; o <<= 1)
#pragma unroll
                    for (int i = 0; i < 16; ++i) ssq[i] += __shfl_xor(ssq[i], o);
                if (r == 0) {
#pragma unroll
                    for (int i = 0; i < 16; ++i) part[crow(i, hi) * 8 + h] = ssq[i];
                }
                __syncthreads();
#pragma unroll
                for (int i = 0; i < 16; ++i) {
                    const int q = crow(i, hi); const f32x4 a = *(const LAS f32x4*)(part + q * 8), c4 = *(const LAS f32x4*)(part + q * 8 + 4);
                    const float s = ((a.x + a.y) + (a.z + a.w)) + ((c4.x + c4.y) + (c4.z + c4.w)); const float rinv = __builtin_amdgcn_rsqf(s * (1.0f / 512.0f) + EPS);
                    bf16_t* yp = YALL + (rowbase + q0 + q) * DM + 512 + h * 64 + r;
                    yp[0] = f2bf(o0[i] * rinv); yp[32] = f2bf(o1[i] * rinv);
                }
                __syncthreads();
            }
        }
        PHASE_END

        PHASE_BEGIN
        {
            LAS float* acT = (LAS float*)lds;
            LAS float* dtT = (LAS float*)(lds + 4096);
            LAS float* part = (LAS float*)(lds + 8192);
            const int h = wave, g = h >> 2;
            for (int u = vcu; u < 256; u += G) {
                const int b = u >> 6, c = (u >> 1) & 31, lh = u & 1; const size_t rowc = (size_t)b * SEQ + c * 128;
                for (int e = tid; e < 1024; e += 512) { const int l = e >> 3, hh = e & 7; acT[hh * 128 + l] = ACUM[(rowc + l) * 8 + hh]; dtT[hh * 128 + l] = DT[(rowc + l) * 8 + hh]; }
                bf16x8 pf[2][4];
                {
                    const float* sp = ST + ((size_t)((b * 32 + c) * 8 + h)) * 4096;
#pragma unroll
                    for (int pt = 0; pt < 2; ++pt)
#pragma unroll
                        for (int k = 0; k < 4; ++k) { const f32x4* q4 = (const f32x4*)(sp + (pt * 32 + r) * 64 + 16 * k + 8 * hi); const f32x4 a = q4[0], c4 = q4[1];
                            pf[pt][k] = pack8(a.x, a.y, a.z, a.w, c4.x, c4.y, c4.z, c4.w); }
                }
                const float dsk = P.d_skip[layer * 8 + h];
                __syncthreads();
                for (int lbi = 0; lbi < 2; ++lbi) {
                    const int lb = lh ? (1 + lbi) : (3 * lbi), l0 = lb * 32;
                    bf16x8 cf[4];
#pragma unroll
                    for (int k = 0; k < 4; ++k) cf[k] = ldg8(BC + (rowc + l0 + r) * 256 + 128 + g * 64 + 16 * k + 8 * hi);
                    f32x16 o0 = {}, o1 = {};
#pragma unroll
                    for (int k = 0; k < 4; ++k) { o0 = MFMA32(cf[k], pf[0][k], o0); o1 = MFMA32(cf[k], pf[1][k], o1); }
#pragma unroll
                    for (int i = 0; i < 16; ++i) { const float e = fexp(acT[h * 128 + l0 + crow(i, hi)]); o0[i] *= e; o1[i] *= e; }
                    const float a_l = acT[h * 128 + l0 + r];
                    for (int sb = 0; sb <= lb; ++sb) {
                        const int s0 = sb * 32;
                        bf16x8 bfr[4], vf[2][2];
#pragma unroll
                        for (int k = 0; k < 4; ++k) bfr[k] = ldg8(BC + (rowc + s0 + pi_row(r)) * 256 + g * 64 + 16 * k + 8 * hi);
#pragma unroll
                        for (int pt = 0; pt < 2; ++pt)
#pragma unroll
                            for (int j = 0; j < 2; ++j) vf[pt][j] = ldg8(XST + ((size_t)((b * 8 + h) * 64 + pt * 32 + r)) * SEQ + c * 128 + s0 + 16 * hi + 8 * j);
                        f32x16 st = {};
#pragma unroll
                        for (int k = 0; k < 4; ++k) st = MFMA32(bfr[k], cf[k], st);
                        float w[16]; const bool diag = (sb == lb);
#pragma unroll
                        for (int q4 = 0; q4 < 4; ++q4) {
                            const f32x4 as = *(const LAS f32x4*)(acT + h * 128 + s0 + 16 * hi + 4 * q4), ds = *(const LAS f32x4*)(dtT + h * 128 + s0 + 16 * hi + 4 * q4);
#pragma unroll
                            for (int e = 0; e < 4; ++e) { const int i = 4 * q4 + e; float p = st[i] * fexp(a_l - as[e]) * ds[e];
                                if (diag) { const int sl = 16 * hi + i; if (sl > r) p = 0.f; if (sl == r) p += dsk; }
                                w[i] = p; }
                        }
                        const bf16x8 pa0 = pack8(w[0], w[1], w[2], w[3], w[4], w[5], w[6], w[7]), pa1 = pack8(w[8], w[9], w[10], w[11], w[12], w[13], w[14], w[15]);
                        o0 = MFMA32(pa0, vf[0][0], o0); o0 = MFMA32(pa1, vf[0][1], o0); o1 = MFMA32(pa0, vf[1][0], o1); o1 = MFMA32(pa1, vf[1][1], o1);
                    }
                    float ssq[16];
#pragma unroll
                    for (int i = 0; i < 16; ++i) {
                        const bf16_t* zp = PJ + (rowc + l0 + crow(i, hi)) * PJW + h * 64 + r;
                        const float z0 = bf2f(zp[0]), z1 = bf2f(zp[32]);
                        o0[i] *= z0 / (1.f + fexp(-z0)); o1[i] *= z1 / (1.f + fexp(-z1));
                        ssq[i] = o0[i] * o0[i] + o1[i] * o1[i];
                    }
#pragma unroll
                    for (int o = 1; o < 32; o <<= 1)
#pragma unroll
                        for (int i = 0; i < 16; ++i) ssq[i] += __shfl_xor(ssq[i], o);
                    LAS float* pp = part + lbi * 256;
                    if (r == 0) {
#pragma unroll
                        for (int i = 0; i < 16; ++i) pp[crow(i, hi) * 8 + h] = ssq[i];
                    }
                    __syncthreads();
#pragma unroll
                    for (int i = 0; i < 16; ++i) {
                        const int q = crow(i, hi); const f32x4 a = *(const LAS f32x4*)(pp + q * 8), c4 = *(const LAS f32x4*)(pp + q * 8 + 4);
                        const float s = ((a.x + a.y) + (a.z + a.w)) + ((c4.x + c4.y) + (c4.z + c4.w)); const float rinv = __builtin_amdgcn_rsqf(s * (1.0f / 512.0f) + EPS);
                        bf16_t* yp = YALL + (rowc + l0 + q) * DM + h * 64 + r;
                        yp[0] = f2bf(o0[i] * rinv); yp[32] = f2bf(o1[i] * rinv);
                    }
                }
                __syncthreads();
            }
        }
        PHASE_END

        PHASE_BEGIN
        {
            pg8::Gemm g{YALL, (const bf16_t*)(wl + WL_OUT), M, DM, DM}; pg8::StaticOrder S; S.init(M, DM, G, bx);
            EpiResid E{layer == 0 ? P.x : P.out, P.out, HB, SS};
            pg8::gemm_phase<EpiResid, pg8::StaticOrder, false, true>(lds, g, S, E, tid);
        }
        PHASE_END

        PHASE_BEGIN
        {
            pg8::Gemm g{HB, (const bf16_t*)(wl + WL_XQ), M, 512, DM}; pg8::StaticOrder S; S.init(M, 512, G, bx);
            EpiScale<0> E{XQ, 512, SS, 0.08838834764831845f};
            pg8::gemm_phase<EpiScale<0>, pg8::StaticOrder, false, true>(lds, g, S, E, tid);
        }
        PHASE_END

        PHASE_BEGIN
        {
            LAS float* lsc = (LAS float*)lds + wave * 32;
            const int h = wave & 3, sub = wave >> 2;
            for (int u = vcu; u < 256; u += G) {
                const int b = u >> 6; const size_t row0 = (size_t)u * 64 + sub * 32;
                bf16x8 qf[8];
#pragma unroll
                for (int k = 0; k < 8; ++k) qf[k] = ldg8(XQ + (row0 + r) * 512 + h * 128 + 16 * k + 8 * hi);
                const bf16_t* Kh = MK + ((size_t)((layer * 4 + b) * 4 + h)) * 256 * 128 + 8 * hi;
                const bf16_t* Vh = MVT + ((size_t)((layer * 4 + b) * 4 + h)) * 128 * 256 + (size_t)r * 256 + 16 * hi;
                float mx = -INFINITY;
                for (int kt = 0; kt < 8; ++kt) {
                    const bf16_t* kp = Kh + (size_t)(kt * 32 + pi_row(r)) * 128; f32x16 st = {};
#pragma unroll
                    for (int k = 0; k < 8; ++k) st = MFMA32(ldg8(kp + 16 * k), qf[k], st);
#pragma unroll
                    for (int i = 0; i < 16; ++i) mx = __builtin_fmaxf(mx, st[i]);
                }
                mx = __builtin_fmaxf(mx, __shfl_xor(mx, 32));
                f32x16 o[4] = {{}, {}, {}, {}}; float lsum = 0.f;
                for (int kt = 0; kt < 8; ++kt) {
                    const bf16_t* kp = Kh + (size_t)(kt * 32 + pi_row(r)) * 128; f32x16 st = {};
#pragma unroll
                    for (int k = 0; k < 8; ++k) st = MFMA32(ldg8(kp + 16 * k), qf[k], st);
                    float w[16];
#pragma unroll
                    for (int i = 0; i < 16; ++i) { w[i] = fexp(st[i] - mx); lsum += w[i]; }
                    const bf16x8 pa0 = pack8(w[0], w[1], w[2], w[3], w[4], w[5], w[6], w[7]), pa1 = pack8(w[8], w[9], w[10], w[11], w[12], w[13], w[14], w[15]);
#pragma unroll
                    for (int d = 0; d < 4; ++d) { o[d] = MFMA32(pa0, ldg8(Vh + (size_t)d * 32 * 256 + kt * 32), o[d]); o[d] = MFMA32(pa1, ldg8(Vh + (size_t)d * 32 * 256 + kt * 32 + 8), o[d]); }
                }
                lsum += __shfl_xor(lsum, 32);
                if (hi == 0) lsc[r] = 1.0f / lsum;
                LDS_WAIT();
#pragma unroll
                for (int i = 0; i < 16; ++i) { const int q = crow(i, hi); const float li = lsc[q];
                    bf16_t* op = XAO + (row0 + q) * 512 + h * 128 + r;
#pragma unroll
                    for (int d = 0; d < 4; ++d) op[d * 32] = f2bf(o[d][i] * li); }
                LDS_WAIT();
            }
        }
        PHASE_END

        PHASE_BEGIN
        {
            pg8::Gemm g{XAO, (const bf16_t*)(wl + WL_XO), M, DM, 512}; pg8::StaticOrder S; S.init(M, DM, G, bx);
            EpiResid E{P.out, P.out, HB, SS};
            pg8::gemm_phase<EpiResid, pg8::StaticOrder, false, true>(lds, g, S, E, tid);
        }
        PHASE_END

        PHASE_BEGIN
        {
            pg8::Gemm g{HB, (const bf16_t*)(wl + WL_FF1), M, DFF, DM}; pg8::StaticOrder S; S.init(M, DFF, G, bx);
            EpiScale<1> E{U, DFF, SS, 1.0f};
            pg8::gemm_phase<EpiScale<1>, pg8::StaticOrder, true, true>(lds, g, S, E, tid);
        }
        PHASE_END

        PHASE_BEGIN
        {
            pg8::Gemm g{U, (const bf16_t*)(wl + WL_FF2), M, DM, DFF}; pg8::StaticOrder S; S.init(M, DM, G, bx);
            EpiResid E{P.out, P.out, HB, SS};
            pg8::gemm_phase<EpiResid, pg8::StaticOrder, false, true>(lds, g, S, E, tid);
        }
        PHASE_END
    }

    PHASE_BEGIN
    {
        const int gw = vcu * 8 + wave, NGW = G * 8;
        for (int m = gw; m < M; m += NGW) {
            const float rs = row_rs(SS, m);
            f32x4* hp = (f32x4*)(P.out + (size_t)m * DM) + lane; const f32x4* gp = (const f32x4*)P.final_g + lane;
#pragma unroll
            for (int j = 0; j < 4; ++j) { const f32x4 v = hp[64 * j], gg = gp[64 * j]; hp[64 * j] = v * rs * gg; }
        }
    }
    }
    ++ph;
}

constexpr int N_PHASES = 2 + 2 * 10 + 1;

extern "C" void kernel_launch(void* const* d_in, const int* in_sizes, int n_in, void* d_out, int out_size, void* d_ws, size_t ws_size, hipStream_t stream) {
    static int grid = 0;
    if (grid == 0) {
        int dev = 0, cus = 0, per_cu = 0;
        hipGetDevice(&dev); hipDeviceGetAttribute(&cus, hipDeviceAttributeMultiprocessorCount, dev);
        hipFuncSetAttribute((const void*)fwd_kernel, hipFuncAttributeMaxDynamicSharedMemorySize, LDS_BYTES);
        hipOccupancyMaxActiveBlocksPerMultiprocessor(&per_cu, (const void*)fwd_kernel, 512, LDS_BYTES);
        if (per_cu < 1) per_cu = 1;
        grid = cus * per_cu;
        if (n_in != 22 || ws_size < WS_END) { fprintf(stderr, "kernel_launch: unexpected n_in %d / ws %zu\n", n_in, ws_size); }
    }
    Params p{};
    const float** pp = (const float**)&p;
    for (int i = 0; i < 22; ++i) pp[i] = (const float*)d_in[i];
    p.out = (float*)d_out; p.ws = (unsigned char*)d_ws;
#ifndef MULTI_LAUNCH
    p.ph_lo = 0; p.ph_hi = N_PHASES;
    void* args[] = {&p};
    hipError_t e = hipLaunchCooperativeKernel((const void*)fwd_kernel, dim3(grid), dim3(512), args, LDS_BYTES, stream);
    if (e != hipSuccess) fprintf(stderr, "cooperative launch failed: %s (grid %d)\n", hipGetErrorString(e), grid);
#else
    for (int i = 0; i < N_PHASES; ++i) { p.ph_lo = i; p.ph_hi = i + 1; hipLaunchKernelGGL(fwd_kernel, dim3(grid), dim3(512), LDS_BYTES, stream, p); }
#endif
}
```

```cpp
#include <hip/hip_runtime.h>
#include <hip/hip_cooperative_groups.h>
#include <cstdio>
#include <cstdint>

namespace cg = cooperative_groups;

#define DI __device__ __forceinline__
#define LAS __attribute__((address_space(3)))
typedef unsigned short bf16_t;
typedef short bf16x8 __attribute__((ext_vector_type(8)));
typedef float f32x4 __attribute__((ext_vector_type(4)));
typedef float f32x2 __attribute__((ext_vector_type(2)));
typedef float f32x16 __attribute__((ext_vector_type(16)));
typedef unsigned u32x4 __attribute__((ext_vector_type(4)));
typedef unsigned u32x2 __attribute__((ext_vector_type(2)));
typedef __bf16 bf16x2_t __attribute__((ext_vector_type(2)));

constexpr int M = 16384, DM = 1024, SEQ = 4096, NB = 4, MEML = 256, DFF = 4096;
constexpr int NPROJ = 3072, PJW = 1280;
constexpr int IN_DIM = 2824;
constexpr float EPS = 1e-5f;

constexpr size_t MiB = 1u << 20;
constexpr size_t WS_W = 1 * MiB;
constexpr size_t WL_IN = 0, WL_OUT = 6 * MiB, WL_XQ = 8 * MiB, WL_XO = 9 * MiB, WL_FF1 = 10 * MiB, WL_FF2 = 18 * MiB, WL_SZ = 26 * MiB;
constexpr size_t WS_WMEM = WS_W + 2 * WL_SZ;
constexpr size_t WS_HB = 57 * MiB;
constexpr size_t WS_XST = WS_HB, WS_BC = WS_HB + 16 * MiB;
constexpr size_t WS_U = 89 * MiB;
constexpr size_t WS_PJ = WS_U, WS_QF = WS_U + 40 * MiB, WS_KF = WS_U + 56 * MiB, WS_VT = WS_U + 72 * MiB, WS_YALL = WS_U + 88 * MiB, WS_XQ = WS_U, WS_XAO = WS_U + 16 * MiB;
constexpr size_t WS_ST = 217 * MiB;
constexpr size_t WS_MK = 233 * MiB, WS_MVT = 235 * MiB;
constexpr size_t WS_SS = 237 * MiB;
constexpr size_t WS_DT = 238 * MiB, WS_ACUM = WS_DT + MiB / 2, WS_DTRAW = 239 * MiB;
constexpr size_t WS_MEMB = 240 * MiB;
constexpr size_t WS_RMEM = 242 * MiB;
constexpr size_t WS_END = 243 * MiB;

constexpr int LDS_BYTES = 147456;

DI unsigned pk2(float lo, float hi) { f32x2 v = {lo, hi}; bf16x2_t b = __builtin_convertvector(v, bf16x2_t); return __builtin_bit_cast(unsigned, b); }
DI float fexp(float x) { return __builtin_amdgcn_exp2f(x * 1.4426950408889634f); }
DI float flog(float x) { return __builtin_amdgcn_logf(x) * 0.6931471805599453f; }
DI float flog1p(float e) { return e < 1e-2f ? e * (1.f - e * (0.5f - e * 0.33333333f)) : flog(1.f + e); }
DI float bf2f(bf16_t v) { return __uint_as_float((unsigned)v << 16); }
DI bf16_t f2bf(float f) { return (bf16_t)(pk2(f, 0.f) & 0xffffu); }
#define GAS __attribute__((address_space(1)))
DI bf16x8 ldg8(const bf16_t* p) { return *(const GAS bf16x8*)p; }
DI void stg2(bf16_t* p, bf16_t v) { *(GAS bf16_t*)p = v; }
DI int crow(int i, int hi) { return (i & 3) + 8 * (i >> 2) + 4 * hi; }
DI int pi_inv(int key) { return 8 * ((key >> 2) & 3) + 4 * (key >> 4) + (key & 3); }
DI int pi_row(int r) { return 16 * ((r >> 2) & 1) + 4 * (r >> 3) + (r & 3); }
#define MFMA32(a, b, c) __builtin_amdgcn_mfma_f32_32x32x16_bf16((a), (b), (c), 0, 0, 0)
DI bf16x8 pack8(float a0, float a1, float a2, float a3, float a4, float a5, float a6, float a7) {
    u32x4 p; p.x = pk2(a0, a1); p.y = pk2(a2, a3); p.z = pk2(a4, a5); p.w = pk2(a6, a7); return __builtin_bit_cast(bf16x8, p);
}
DI void store_row32(bf16_t* rowp, const f32x16& o, float sc, int hi) {
#pragma unroll
    for (int m = 0; m < 2; ++m) {
        unsigned ax = pk2(o[8 * m] * sc, o[8 * m + 1] * sc), ay = pk2(o[8 * m + 2] * sc, o[8 * m + 3] * sc), bx = pk2(o[8 * m + 4] * sc, o[8 * m + 5] * sc), by = pk2(o[8 * m + 6] * sc, o[8 * m + 7] * sc);
        { auto t = __builtin_amdgcn_permlane32_swap(ax, bx, false, false); ax = t[0]; bx = t[1]; }
        { auto t = __builtin_amdgcn_permlane32_swap(ay, by, false, false); ay = t[0]; by = t[1]; }
        *(GAS u32x4*)(rowp + 16 * m + 8 * hi) = (u32x4){ax, ay, bx, by};
    }
}
DI float wave_sum(float v) {
#pragma unroll
    for (int o = 1; o < 64; o <<= 1) v += __shfl_xor(v, o);
    return v;
}
DI float row_rs(const float* SS, int row) {
    const f32x4* p = (const f32x4*)(SS + (size_t)row * 16); const f32x4 a = p[0], b = p[1], c = p[2], d = p[3];
    const float s = ((a.x + a.y) + (a.z + a.w)) + ((b.x + b.y) + (b.z + b.w)) + ((c.x + c.y) + (c.z + c.w)) + ((d.x + d.y) + (d.z + d.w));
    return __builtin_amdgcn_rsqf(s * (1.0f / 1024.0f) + EPS);
}

namespace pg8 {
#define PG8_LAS __attribute__((address_space(3)))
constexpr int BM = 256, BK = 64, HALF = 128, HTB = HALF * BK * 2, STAGE_BYTES = 8 * HTB, NXCD = 8, WGM = 8;
__host__ __device__ __forceinline__ int lds_byte(int r, int c) { const int st = (r >> 4) * 2 + (c >> 5), rr = r & 15, cc = c & 31, ob = rr * 64 + cc * 2; return st * 1024 + (ob ^ (((ob >> 9) & 1) << 5)); }
__host__ __device__ __forceinline__ void stage_rc(int b, int& R, int& C) { const int st = b / 1024, sb = b % 1024, swz = sb ^ (((sb >> 9) & 1) << 5); R = (st >> 1) * 16 + swz / 64; C = (st & 1) * 32 + (swz % 64) / 2; }
__host__ __device__ __forceinline__ int perm32(int rho) { const int n = rho >> 4, i = rho & 15; return 8 * (i >> 2) + 4 * n + (i & 3); }
struct Unit { int pm, pn; };
struct Gemm { const bf16_t* A; const bf16_t* Bt; int M, N, K; };
struct StaticOrder {
    int nM, nN, nwg, G, c;
    __host__ __device__ void init(int M_, int N_, int G_, int c_) { nM = M_ / BM; nN = N_ / BM; nwg = nM * nN; G = G_; c = c_; }
    __host__ __device__ __forceinline__ bool next(int i, Unit& u) const {
        const long L = (long)i * G + c; if (L >= nwg) return false;
        int wgid = (int)L; { const int q = nwg / NXCD, r = nwg % NXCD, xcd = wgid % NXCD, off = wgid / NXCD; wgid = (xcd < r ? xcd * (q + 1) : r * (q + 1) + (xcd - r) * q) + off; }
        const int nig = WGM * nN, gid = wgid / nig, fm = gid * WGM, gsz = (nM - fm) < WGM ? (nM - fm) : WGM;
        u.pm = fm + ((wgid % nig) % gsz); u.pn = (wgid % nig) / gsz; return true;
    }
    __device__ __forceinline__ void a_ready(const Unit&) const {}
    __device__ __forceinline__ void done(const Unit&) const {}
};

template <class Epi, class Sched, bool ALIGN_EPI = false, bool SP2 = false>
__device__ __forceinline__ void gemm_phase(PG8_LAS unsigned char* lds, const Gemm g, const Sched& S, const Epi& E, const int tid) {
    const int wid = __builtin_amdgcn_readfirstlane(tid >> 6), lane = tid & 63, wr = wid >> 2, wc = wid & 3, fr = lane & 15, fq = lane >> 4;
    const int K = g.K, nt = K / BK;
    unsigned voffA[2], voffB[2];
#pragma unroll
    for (int i = 0; i < 2; ++i) { int R, C; stage_rc(tid * 16 + i * 8192, R, C); const int Rb = Epi::PERM ? ((R & ~31) + perm32(R & 31)) : R;
        voffA[i] = (unsigned)(R * K + C) * 2u; voffB[i] = (unsigned)(Rb * K + C) * 2u; }
    const size_t kstep = (size_t)(BK * 2);
    const size_t hstep = (size_t)HALF * K * 2;
    const size_t tstep = 2 * hstep;
    const unsigned ldsw = (unsigned)wid * 1024u;
    const int aoff = lds_byte(wr * 64 + fr, fq * 8), boff = lds_byte(wc * 32 + fr, fq * 8);
#define PG8_SA(b, h) (((b) * 2 + (h)) * HTB)
#define PG8_SB(b, h) ((4 + (b) * 2 + (h)) * HTB)
#define PG8_STAGE(bufoff, gbase, voff) do { _Pragma("unroll") for (int _i = 0; _i < 2; ++_i) \
        __builtin_amdgcn_global_load_lds((const unsigned*)((const char*)(gbase) + (voff)[_i]), (PG8_LAS unsigned*)(lds + (bufoff) + ldsw + _i * 8192), 16, 0, 0); } while (0)
#define PG8_LDA(dst, b, h) do { _Pragma("unroll") for (int m = 0; m < 4; ++m) _Pragma("unroll") for (int k = 0; k < 2; ++k) dst[m][k] = *(const PG8_LAS bf16x8*)(lds + PG8_SA(b, h) + aoff + m * 2048 + k * 1024); } while (0)
#define PG8_LDB(dst, b, h) do { _Pragma("unroll") for (int n = 0; n < 2; ++n) _Pragma("unroll") for (int k = 0; k < 2; ++k) dst[n][k] = *(const PG8_LAS bf16x8*)(lds + PG8_SB(b, h) + boff + n * 2048 + k * 1024); } while (0)
#define PG8_MMA(ai, bj, At, Bt) do { __builtin_amdgcn_s_setprio(1); _Pragma("unroll") for (int m = 0; m < 4; ++m) _Pragma("unroll") for (int n = 0; n < 2; ++n) _Pragma("unroll") for (int k = 0; k < 2; ++k) \
        acc[ai][bj][m][n] = __builtin_amdgcn_mfma_f32_16x16x32_bf16(Bt[n][k], At[m][k], acc[ai][bj][m][n], 0, 0, 0); __builtin_amdgcn_s_setprio(0); } while (0)
#define PG8_WAIT_V(n) asm volatile("s_waitcnt vmcnt(" #n ")" ::: "memory")
#define PG8_WAIT_L(n) asm volatile("s_waitcnt lgkmcnt(" #n ")" ::: "memory")
#define PG8_BAR __builtin_amdgcn_s_barrier()
#define PG8_SCHED __builtin_amdgcn_sched_barrier(0)
    Unit cur, nxt; int ui = 0;
    if (!S.next(0, cur)) return;
    f32x4 acc[2][2][4][2];
#pragma unroll
    for (int a = 0; a < 2; ++a)
#pragma unroll
        for (int b = 0; b < 2; ++b)
#pragma unroll
            for (int m = 0; m < 4; ++m)
#pragma unroll
                for (int n = 0; n < 2; ++n) acc[a][b][m][n] = (f32x4){0.f, 0.f, 0.f, 0.f};
    bf16x8 At[4][2], B0[2][2], B1[2][2];
    const char* cA = (const char*)g.A + (size_t)cur.pm * tstep; const char* cB = (const char*)g.Bt + (size_t)cur.pn * tstep;
    S.a_ready(cur);
    if constexpr (SP2) {
        PG8_STAGE(PG8_SB(0, 0), cB, voffB); PG8_STAGE(PG8_SB(0, 1), cB + hstep, voffB); PG8_STAGE(PG8_SA(0, 0), cA, voffA); PG8_STAGE(PG8_SA(0, 1), cA + hstep, voffA);
        if (wr == 1) PG8_BAR;
        PG8_WAIT_V(2); PG8_BAR;
        PG8_STAGE(PG8_SB(1, 0), cB + kstep, voffB); PG8_STAGE(PG8_SA(1, 0), cA + kstep, voffA); PG8_STAGE(PG8_SB(1, 1), cB + hstep + kstep, voffB);
        PG8_WAIT_V(6); PG8_BAR;
    } else {
        PG8_STAGE(PG8_SB(0, 0), cB, voffB); PG8_STAGE(PG8_SA(0, 0), cA, voffA); PG8_STAGE(PG8_SB(0, 1), cB + hstep, voffB); PG8_STAGE(PG8_SA(0, 1), cA + hstep, voffA);
        if (wr == 1) PG8_BAR;
        PG8_WAIT_V(4); PG8_BAR;
        PG8_STAGE(PG8_SB(1, 0), cB + kstep, voffB); PG8_STAGE(PG8_SA(1, 0), cA + kstep, voffA); PG8_STAGE(PG8_SB(1, 1), cB + hstep + kstep, voffB);
        PG8_WAIT_V(6); PG8_BAR;
    }
    for (;;) {
        const bool has_next = S.next(ui + 1, nxt);
        const char* nA = has_next ? (const char*)g.A + (size_t)nxt.pm * tstep : cA; const char* nB = has_next ? (const char*)g.Bt + (size_t)nxt.pn * tstep : cB;
        for (int t = 0; t < nt; t += 2) {
            const bool last = (t == nt - 2);
            const char* a1 = cA + (size_t)(t + 1) * kstep;
            const char* a2 = last ? nA : cA + (size_t)(t + 2) * kstep; const char* b2 = last ? nB : cB + (size_t)(t + 2) * kstep;
            const char* a3 = a2 + kstep; const char* b3 = b2 + kstep;
            if (last && has_next) S.a_ready(nxt);
            if constexpr (SP2) {
            PG8_LDB(B0, 0, 0); PG8_LDB(B1, 0, 1); PG8_SCHED; PG8_LDA(At, 0, 0); PG8_STAGE(PG8_SA(1, 1), a1 + hstep, voffA);
            PG8_WAIT_V(8); PG8_WAIT_L(0); PG8_BAR; PG8_MMA(0, 0, At, B0); PG8_MMA(0, 1, At, B1); PG8_BAR; PG8_SCHED;
            PG8_LDA(At, 0, 1); PG8_STAGE(PG8_SB(0, 0), b2, voffB); PG8_STAGE(PG8_SB(0, 1), b2 + hstep, voffB); PG8_STAGE(PG8_SA(0, 0), a2, voffA);
            PG8_WAIT_V(8); PG8_WAIT_L(0); PG8_BAR; PG8_MMA(1, 0, At, B0); PG8_MMA(1, 1, At, B1); PG8_BAR; PG8_SCHED;
            PG8_LDB(B0, 1, 0); PG8_LDB(B1, 1, 1); PG8_SCHED; PG8_LDA(At, 1, 0); PG8_STAGE(PG8_SA(0, 1), a2 + hstep, voffA);
            PG8_WAIT_V(8); PG8_WAIT_L(0); PG8_BAR; PG8_MMA(0, 0, At, B0); PG8_MMA(0, 1, At, B1); PG8_BAR; PG8_SCHED;
            PG8_LDA(At, 1, 1); PG8_STAGE(PG8_SB(1, 0), b3, voffB); PG8_STAGE(PG8_SB(1, 1), b3 + hstep, voffB); PG8_STAGE(PG8_SA(1, 0), a3, voffA);
            PG8_WAIT_V(8); PG8_WAIT_L(0); PG8_BAR; PG8_MMA(1, 0, At, B0); PG8_MMA(1, 1, At, B1); PG8_BAR; PG8_SCHED;
            } else {
            PG8_LDB(B0, 0, 0); PG8_SCHED; PG8_LDA(At, 0, 0); PG8_STAGE(PG8_SA(1, 1), a1 + hstep, voffA);
            PG8_WAIT_L(8); PG8_BAR; PG8_WAIT_L(0); PG8_MMA(0, 0, At, B0); PG8_BAR; PG8_SCHED;
            PG8_LDB(B1, 0, 1); PG8_STAGE(PG8_SB(0, 0), b2, voffB);
            PG8_BAR; PG8_WAIT_L(0); PG8_MMA(0, 1, At, B1); PG8_BAR;
            PG8_LDA(At, 0, 1); PG8_STAGE(PG8_SA(0, 0), a2, voffA);
            PG8_BAR; PG8_WAIT_L(0); PG8_MMA(1, 0, At, B0); PG8_BAR; PG8_SCHED;
            PG8_STAGE(PG8_SB(0, 1), b2 + hstep, voffB);
            PG8_WAIT_V(6); PG8_BAR; PG8_MMA(1, 1, At, B1); PG8_BAR;
            PG8_LDB(B0, 1, 0); PG8_SCHED; PG8_LDA(At, 1, 0); PG8_STAGE(PG8_SA(0, 1), a2 + hstep, voffA);
            PG8_WAIT_L(8); PG8_BAR; PG8_WAIT_L(0); PG8_MMA(0, 0, At, B0); PG8_BAR; PG8_SCHED;
            PG8_LDB(B1, 1, 1); PG8_STAGE(PG8_SB(1, 0), b3, voffB);
            PG8_BAR; PG8_WAIT_L(0); PG8_MMA(0, 1, At, B1); PG8_BAR;
            PG8_LDA(At, 1, 1); PG8_STAGE(PG8_SA(1, 0), a3, voffA);
            PG8_BAR; PG8_WAIT_L(0); PG8_MMA(1, 0, At, B0); PG8_BAR; PG8_SCHED;
            PG8_STAGE(PG8_SB(1, 1), b3 + hstep, voffB);
            PG8_WAIT_V(6); PG8_BAR; PG8_MMA(1, 1, At, B1); PG8_BAR;
            }
        }
        if constexpr (ALIGN_EPI) { if (wr == 0) PG8_BAR; }
        if constexpr (!Epi::AFTER_DRAIN) { E(acc, cur, wr, wc, fr, fq, ui); } S.done(cur);
        if (!has_next) break;
#pragma unroll
        for (int a = 0; a < 2; ++a)
#pragma unroll
            for (int b = 0; b < 2; ++b)
#pragma unroll
                for (int m = 0; m < 4; ++m)
#pragma unroll
                    for (int n = 0; n < 2; ++n) acc[a][b][m][n] = (f32x4){0.f, 0.f, 0.f, 0.f};
        cur = nxt; cA = nA; cB = nB; ++ui;
        if constexpr (ALIGN_EPI) { if (wr == 1) PG8_BAR; }
    }
    PG8_WAIT_V(0);
    if constexpr (!ALIGN_EPI) { if (wr == 0) PG8_BAR; }
    PG8_BAR;
    if constexpr (Epi::AFTER_DRAIN) E.fused(acc, cur, wr, wc, fr, fq, lds, wid, lane);
#undef PG8_SA
#undef PG8_SB
#undef PG8_STAGE
#undef PG8_LDA
#undef PG8_LDB
#undef PG8_MMA
#undef PG8_WAIT_V
#undef PG8_WAIT_L
#undef PG8_BAR
#undef PG8_SCHED
}
}
using pg8::Unit;

DI void stwt16(void* p, u32x4 w) { asm volatile("global_store_dwordx4 %0, %1, off sc1\n\ts_nop 1" :: "v"(p), "v"(w) : "memory"); }
DI void st8(bf16_t* p, f32x4 v0, f32x4 v1) { u32x4 w; w.x = pk2(v0[0], v0[1]); w.y = pk2(v0[2], v0[3]); w.z = pk2(v1[0], v1[1]); w.w = pk2(v1[2], v1[3]); stwt16(p, w); }

DI u32x4 tr8x8(u32x4 p, int i) {
    {   const bool up = (i & 4) != 0; const unsigned s0 = up ? p.x : p.z, s1 = up ? p.y : p.w;
        const unsigned r0 = __shfl_xor(s0, 4), r1 = __shfl_xor(s1, 4);
        p.x = up ? r0 : p.x; p.y = up ? r1 : p.y; p.z = up ? p.z : r0; p.w = up ? p.w : r1; }
    {   const bool up = (i & 2) != 0; const unsigned s0 = up ? p.x : p.y, s1 = up ? p.z : p.w;
        const unsigned r0 = __shfl_xor(s0, 2), r1 = __shfl_xor(s1, 2);
        p.x = up ? r0 : p.x; p.z = up ? r1 : p.z; p.y = up ? p.y : r0; p.w = up ? p.w : r1; }
    {   const bool up = (i & 1) != 0;
#pragma unroll
        for (int k = 0; k < 4; ++k) { const unsigned q = __shfl_xor(p[k], 1); const unsigned a = (q >> 16) | (p[k] & 0xffff0000u), c = (p[k] & 0xffffu) | (q << 16); p[k] = up ? a : c; } }
    return p;
}
struct EpiProj {
    static constexpr bool PERM = true, AFTER_DRAIN = false;
    bf16_t* PJ; bf16_t* QF; bf16_t* KF; bf16_t* VT; float* DTRAW; const LAS float* rsl;
    DI void operator()(const f32x4 (&acc)[2][2][4][2], const Unit& u, int wr, int wc, int fr, int fq, int ui) const {
        const int row0 = u.pm * 256 + wr * 64 + fr;
#pragma unroll
        for (int ai = 0; ai < 2; ++ai)
#pragma unroll
            for (int m = 0; m < 4; ++m) {
                const int row = row0 + ai * 128 + m * 16; const float rs = rsl[ui * 256 + (row & 255)];
#pragma unroll
                for (int bj = 0; bj < 2; ++bj) {
                    const f32x4 v0 = acc[ai][bj][m][0] * rs, v1 = acc[ai][bj][m][1] * rs; const int col = u.pn * 256 + bj * 128 + wc * 32 + 8 * fq;
                    const int b = row >> 12, t = row & 4095;
                    if (u.pn < 5) st8(PJ + (size_t)row * PJW + col, v0, v1);
                    else if (u.pn < 9) {
                        const bool isk = u.pn >= 7; const int cp = col - (isk ? 1792 : 1280), head = cp >> 6, d = cp & 63;
                        const int ln = ((d >> 3) & 1) * 32 + (isk ? pi_inv(t & 31) : (t & 31));
                        st8((isk ? KF : QF) + ((size_t)(((b * 8 + head) * 128 + (t >> 5)) * 4 + (d >> 4))) * 512 + ln * 8, v0, v1); }
                    else if (u.pn < 11) {
                        const int cp = col - 2304, head = cp >> 6, i8 = fr & 7, d = (cp & 63) + i8, t0 = t & ~7;
                        u32x4 w; w.x = pk2(v0[0], v0[1]); w.y = pk2(v0[2], v0[3]); w.z = pk2(v1[0], v1[1]); w.w = pk2(v1[2], v1[3]);
                        w = tr8x8(w, i8);
                        stwt16(VT + ((size_t)((((b * 8 + head) * 128 + (t0 >> 5)) * 2 + (d >> 5)) * 2 + ((t0 >> 3) & 1))) * 512 + (((t0 >> 4) & 1) * 32 + (d & 31)) * 8, w); }
                    else if (bj == 0 && wc == 0 && fq == 0) { *(f32x4*)(DTRAW + (size_t)row * 8) = v0; *(f32x4*)(DTRAW + (size_t)row * 8 + 4) = v1; }
                }
            }
    }
};
struct EpiResid {
    static constexpr bool PERM = true, AFTER_DRAIN = false;
    bf16_t* HB; float* SS;
    DI void operator()(const f32x4 (&acc)[2][2][4][2], const Unit& u, int wr, int wc, int fr, int fq, int ui) const {
        const int row0 = u.pm * 256 + wr * 64 + fr, col0 = u.pn * 256 + wc * 32 + 8 * fq;
#pragma unroll
        for (int ai = 0; ai < 2; ++ai) {
            u32x4 hbv[4][2];
#pragma unroll
            for (int m = 0; m < 4; ++m)
#pragma unroll
                for (int bj = 0; bj < 2; ++bj) hbv[m][bj] = *(const GAS u32x4*)(HB + (size_t)(row0 + ai * 128 + m * 16) * DM + col0 + bj * 128);
#pragma unroll
            for (int m = 0; m < 4; ++m) {
                const int row = row0 + ai * 128 + m * 16; bf16_t* hp = HB + (size_t)row * DM + col0; float s = 0.f;
#pragma unroll
                for (int bj = 0; bj < 2; ++bj) {
                    const u32x4 hb = hbv[m][bj]; u32x4 w;
#pragma unroll
                    for (int e = 0; e < 4; ++e) {
                        const float a0 = (e < 2 ? acc[ai][bj][m][0][2 * e] : acc[ai][bj][m][1][2 * e - 4]), a1 = (e < 2 ? acc[ai][bj][m][0][2 * e + 1] : acc[ai][bj][m][1][2 * e - 3]);
                        const float v0 = __uint_as_float(hb[e] << 16) + a0, v1 = __uint_as_float(hb[e] & 0xffff0000u) + a1;
                        const unsigned pk = pk2(v0, v1); w[e] = pk;
                        const float r0 = __uint_as_float(pk << 16), r1 = __uint_as_float(pk & 0xffff0000u); s += r0 * r0 + r1 * r1;
                    }
                    stwt16(hp + bj * 128, w);
                }
                s += __shfl_xor(s, 16); s += __shfl_xor(s, 32);
                if (fq == 0) *(GAS float*)(SS + (size_t)row * 16 + u.pn * 4 + wc) = s;
            }
        }
    }
};
struct EpiFinal {
    static constexpr bool PERM = true, AFTER_DRAIN = true;
    const bf16_t* HB; float* out; const float* fg; float* xch; unsigned* cnt;
    DI void operator()(const f32x4 (&)[2][2][4][2], const Unit&, int, int, int, int, int) const {}
    DI void fused(f32x4 (&acc)[2][2][4][2], const Unit& u, int wr, int wc, int fr, int fq, LAS unsigned char* lds, int wid, int lane) const {
        LAS float* Pt = (LAS float*)lds;
        LAS float* St = (LAS float*)(lds + 4096);
        const int row0 = u.pm * 256 + wr * 64 + fr, col0 = u.pn * 256 + wc * 32 + 8 * fq;
#pragma unroll
        for (int ai = 0; ai < 2; ++ai) {
            u32x4 hbv[4][2];
#pragma unroll
            for (int m = 0; m < 4; ++m)
#pragma unroll
                for (int bj = 0; bj < 2; ++bj) hbv[m][bj] = *(const GAS u32x4*)(HB + (size_t)(row0 + ai * 128 + m * 16) * DM + col0 + bj * 128);
#pragma unroll
            for (int m = 0; m < 4; ++m) { float s = 0.f;
#pragma unroll
                for (int bj = 0; bj < 2; ++bj) { const u32x4 hb = hbv[m][bj];
#pragma unroll
                    for (int e = 0; e < 4; ++e) { const int n = e >> 1, j = (e & 1) * 2;
                        const float v0 = __uint_as_float(hb[e] << 16) + acc[ai][bj][m][n][j], v1 = __uint_as_float(hb[e] & 0xffff0000u) + acc[ai][bj][m][n][j + 1];
                        acc[ai][bj][m][n][j] = v0; acc[ai][bj][m][n][j + 1] = v1; s += v0 * v0 + v1 * v1; } }
                s += __shfl_xor(s, 16); s += __shfl_xor(s, 32);
                if (fq == 0) Pt[(wr * 64 + ai * 128 + m * 16 + fr) * 4 + wc] = s; }
        }
        __syncthreads();
        int t = threadIdx.x; asm volatile("" : "+v"(t));
        if (t < 256) { const f32x4 p = *(const LAS f32x4*)(Pt + t * 4);
            __hip_atomic_store(xch + (size_t)(u.pm * 256 + t) * 4 + u.pn, (p.x + p.y) + (p.z + p.w), __ATOMIC_RELAXED, __HIP_MEMORY_SCOPE_AGENT); }
        asm volatile("s_waitcnt vmcnt(0)" ::: "memory");
        if (t < 256 && lane == 0) __hip_atomic_fetch_add(cnt + 64 * u.pm, 1u, __ATOMIC_RELAXED, __HIP_MEMORY_SCOPE_AGENT);
        if (wid == 0) { unsigned sp = 0;
            while ((unsigned)__builtin_amdgcn_readfirstlane(__hip_atomic_load(cnt + 64 * u.pm, __ATOMIC_RELAXED, __HIP_MEMORY_SCOPE_AGENT)) < 16u) { __builtin_amdgcn_s_sleep(1); if (++sp > (1u << 22)) break; }
            __builtin_amdgcn_fence(__ATOMIC_ACQUIRE, "agent"); }
        asm volatile("s_waitcnt vmcnt(0) lgkmcnt(0)" ::: "memory");
        __syncthreads();
        if (t < 256) { const float* sl = xch + (size_t)(u.pm * 256 + t) * 4; float q = 0.f;
#pragma unroll
            for (int k = 0; k < 4; ++k) q += __hip_atomic_load(sl + k, __ATOMIC_RELAXED, __HIP_MEMORY_SCOPE_AGENT);
            St[t] = __builtin_amdgcn_rsqf(q * (1.0f / 1024.0f) + EPS); }
        __syncthreads();
        f32x4 g[2][2];
#pragma unroll
        for (int bj = 0; bj < 2; ++bj) { g[bj][0] = *(const GAS f32x4*)(fg + col0 + bj * 128); g[bj][1] = *(const GAS f32x4*)(fg + col0 + bj * 128 + 4); }
#pragma unroll
        for (int ai = 0; ai < 2; ++ai)
#pragma unroll
            for (int m = 0; m < 4; ++m) { const int lr = wr * 64 + ai * 128 + m * 16 + fr; const float rs = St[lr]; float* op = out + (size_t)(u.pm * 256 + lr) * DM + col0;
#pragma unroll
                for (int bj = 0; bj < 2; ++bj) { *(GAS f32x4*)(op + bj * 128) = acc[ai][bj][m][0] * rs * g[bj][0]; *(GAS f32x4*)(op + bj * 128 + 4) = acc[ai][bj][m][1] * rs * g[bj][1]; } }
    }
};
template <int ACT> struct EpiScale {
    static constexpr bool PERM = true, AFTER_DRAIN = false;
    bf16_t* O; int ldc; const LAS float* rsl;
    DI void operator()(const f32x4 (&acc)[2][2][4][2], const Unit& u, int wr, int wc, int fr, int fq, int ui) const {
        const int row0 = u.pm * 256 + wr * 64 + fr;
#pragma unroll
        for (int ai = 0; ai < 2; ++ai)
#pragma unroll
            for (int m = 0; m < 4; ++m) {
                const int row = row0 + ai * 128 + m * 16; const float rs = rsl[ui * 256 + (row & 255)];
#pragma unroll
                for (int bj = 0; bj < 2; ++bj) {
                    f32x4 v0 = acc[ai][bj][m][0] * rs, v1 = acc[ai][bj][m][1] * rs;
                    if (ACT == 1) {
#pragma unroll
                        for (int e = 0; e < 4; ++e) { const float a = __builtin_fmaxf(v0[e], 0.f), b = __builtin_fmaxf(v1[e], 0.f); v0[e] = a * a; v1[e] = b * b; }
                    }
                    { u32x4 w; w.x = pk2(v0[0], v0[1]); w.y = pk2(v0[2], v0[3]); w.z = pk2(v1[0], v1[1]); w.w = pk2(v1[2], v1[3]);
                        const int col = u.pn * 256 + bj * 128 + wc * 32 + 8 * fq;
                        if (ACT == 0) {
                            const int hd = col >> 7, d = col & 127;
                            *(GAS u32x4*)(O + ((size_t)(((row >> 5) * 4 + hd) * 8 + (d >> 4))) * 512 + (((d >> 3) & 1) * 32 + (row & 31)) * 8) = w;
                        } else *(GAS u32x4*)(O + (size_t)row * ldc + col) = w; }
                }
            }
    }
};
struct EpiMem {
    static constexpr bool PERM = true, AFTER_DRAIN = false;
    bf16_t* MK; bf16_t* MVT; const float* RMEM;
    DI void operator()(const f32x4 (&acc)[2][2][4][2], const Unit& u, int wr, int wc, int fr, int fq, int ui) const {
        const int row0 = u.pm * 256 + wr * 64 + fr;
#pragma unroll
        for (int ai = 0; ai < 2; ++ai)
#pragma unroll
            for (int m = 0; m < 4; ++m) {
                const int row = row0 + ai * 128 + m * 16; const float rs = RMEM[row]; const int b = row >> 8, mm = row & 255;
#pragma unroll
                for (int bj = 0; bj < 2; ++bj) {
                    const f32x4 v0 = acc[ai][bj][m][0] * rs, v1 = acc[ai][bj][m][1] * rs; const int c = u.pn * 256 + bj * 128 + wc * 32 + 8 * fq;
                    const int layer = c >> 10, kv = (c >> 9) & 1, head = (c >> 7) & 3, d = c & 127;
                    const size_t hb = (size_t)((layer * 4 + b) * 4 + head) * 32768;
                    if (kv == 0) st8(MK + hb + ((size_t)((mm >> 5) * 8 + (d >> 4))) * 512 + (((d >> 3) & 1) * 32 + pi_inv(mm & 31)) * 8, v0, v1);
                    else { bf16_t* p = MVT + hb + ((size_t)(((mm >> 5) * 4 + (d >> 5)) * 2 + ((mm >> 3) & 1))) * 512 + (((mm >> 4) & 1) * 32 + (d & 31)) * 8 + (mm & 7);
                        stg2(p, f2bf(v0[0])); stg2(p + 8, f2bf(v0[1])); stg2(p + 16, f2bf(v0[2])); stg2(p + 24, f2bf(v0[3]));
                        stg2(p + 32, f2bf(v1[0])); stg2(p + 40, f2bf(v1[1])); stg2(p + 48, f2bf(v1[2])); stg2(p + 56, f2bf(v1[3])); }
                }
            }
    }
};


#define RLX_AGENT __ATOMIC_RELAXED, __HIP_MEMORY_SCOPE_AGENT
#define XB_TMO      128
#define XB_XCNT(j)  (256  + 64 * (j))
#define XB_XSUB(j)  (1280 + 64 * (j))
#define XB_XGEN(j)  (2304 + 64 * (j))
#define XB_TOP      3328
#define XB_TOPGEN   3392
#define XCD_BAR_WORDS 3456
#define XB_SPIN_CAP (1u << 18)
DI unsigned xb_ld(unsigned* p)              { return __hip_atomic_load(p, __ATOMIC_RELAXED, __HIP_MEMORY_SCOPE_AGENT); }
DI unsigned xb_add(unsigned* p, unsigned v) { return __hip_atomic_fetch_add(p, v, __ATOMIC_RELAXED, __HIP_MEMORY_SCOPE_AGENT); }
DI unsigned xb_xcc_id() { return (unsigned)__builtin_amdgcn_s_getreg((3 << 11) | 20) & 0xFu; }
#define XB_SPIN(cond, bar) do { unsigned _sp = 0; while (cond) { __builtin_amdgcn_s_sleep(1); \
    if ((++_sp & 255u) == 0u) { if (xb_ld(&(bar)[XB_TMO])) break; if (_sp > XB_SPIN_CAP) { atomicAdd(&(bar)[XB_TMO], 1u); break; } } } } while (0)
struct XcdBarrier { unsigned* bar; unsigned x; volatile LAS unsigned* st; };
DI XcdBarrier xcd_barrier_post(unsigned* bar, volatile LAS unsigned* st) {
    XcdBarrier b; b.bar = bar; b.x = xb_xcc_id(); b.st = st;
    if (threadIdx.x == 0) (void)xb_add(&bar[XB_XCNT(b.x)], 1u);
    return b;
}
DI void xcd_barrier_complete(unsigned* bar, unsigned x, unsigned& nloc, unsigned& nx) {
    const unsigned G = gridDim.x * gridDim.y * gridDim.z;
    unsigned sum, cnt, mine, sp = 0u;
    for (;;) {
        sum = 0u; cnt = 0u; mine = 0u;
#pragma unroll
        for (unsigned j = 0; j < 16; ++j) { const unsigned c = xb_ld(&bar[XB_XCNT(j)]); sum += c; cnt += (c > 0u) ? 1u : 0u; mine = (j == x) ? c : mine; }
        if (sum == G) break;
        __builtin_amdgcn_s_sleep(1);
        if ((++sp & 255u) == 0u) { if (xb_ld(&bar[XB_TMO])) break; if (sp > XB_SPIN_CAP) { atomicAdd(&bar[XB_TMO], 1u); break; } }
    }
    nloc = mine > 0u ? mine : 1u; nx = cnt > 0u ? cnt : 1u;
}
DI void xcd_barrier(const XcdBarrier& b) {
    asm volatile("s_waitcnt vmcnt(0)" ::: "memory");
    __syncthreads();
    if (threadIdx.x == 0) {
        unsigned* bar = b.bar;
        __builtin_amdgcn_s_waitcnt(0);
        unsigned nloc = b.st[0], nx = b.st[1];
        if (nloc == 0u) { xcd_barrier_complete(bar, b.x, nloc, nx); b.st[0] = nloc; b.st[1] = nx; }
        const unsigned old = xb_add(&bar[XB_XSUB(b.x)], 1u);
        const unsigned gen = old / nloc;
        if (old + 1u == (gen + 1u) * nloc) {
            __builtin_amdgcn_fence(__ATOMIC_RELEASE, "agent");
            asm volatile("s_waitcnt vmcnt(0)" ::: "memory");
            const unsigned og = xb_add(&bar[XB_TOP], 1u);
            const unsigned tg = og / nx;
            if (og + 1u == (tg + 1u) * nx) xb_add(&bar[XB_TOPGEN], 1u);
            else XB_SPIN(xb_ld(&bar[XB_TOPGEN]) == tg, bar);
            __builtin_amdgcn_fence(__ATOMIC_ACQUIRE, "agent");
            xb_add(&bar[XB_XGEN(b.x)], 1u);
            asm volatile("s_waitcnt vmcnt(0)" ::: "memory");
        } else {
            XB_SPIN(xb_ld(&bar[XB_XGEN(b.x)]) == gen, bar);
            __builtin_amdgcn_fence(__ATOMIC_ACQUIRE, "agent");
            asm volatile("s_waitcnt vmcnt(0)" ::: "memory");
        }
    }
    __syncthreads();
}

struct Params {
    const float* x; const float* mem; const float* norm_mix_g; const float* w_in; const float* conv_w; const float* conv_b; const float* dt_bias; const float* a_log;
    const float* d_skip; const float* ssd_norm_g; const float* sb_norm_g; const float* w_out; const float* norm_xa_g; const float* norm_mem_g;
    const float* w_xq; const float* w_xk; const float* w_xv; const float* w_xo; const float* norm_ff_g; const float* w_ff1; const float* w_ff2; const float* final_g;
    float* out; unsigned char* ws; int ph_lo, ph_hi;
};

#define LDS_WAIT() asm volatile("s_waitcnt lgkmcnt(0)" ::: "memory")

struct TDesc { const float* W; bf16_t* WT; const float* g1; const float* g2; int K, N, gsplit, mode, item; };
DI void tr_load(const TDesc& d, int lane, f32x4 (&v)[16], float (&gv)[16]) {
    const int nblk = (d.N + 63) / 64, kb = d.item / nblk, nb = d.item % nblk, k0 = 64 * kb, n0 = 64 * nb;
    const int n4 = lane & 15, sub = lane >> 4, n = n0 + 4 * n4; const bool ok = n < d.N;
#pragma unroll
    for (int i = 0; i < 16; ++i) v[i] = ok ? __builtin_nontemporal_load((const GAS f32x4*)(d.W + (size_t)(k0 + 4 * i + sub) * d.N + n)) : (f32x4){0.f, 0.f, 0.f, 0.f};
#pragma unroll
    for (int i = 0; i < 16; ++i) { const int kg = k0 + 4 * i + sub; gv[i] = d.mode == 2 ? 1.f : (kg < d.gsplit ? d.g1[kg] : d.g2[kg - d.gsplit]); }
}
DI void tr_finish(const TDesc& d, int lane, const f32x4 (&v)[16], const float (&gv)[16], LAS float* scr) {
    const int nblk = (d.N + 63) / 64, kb = d.item / nblk, nb = d.item % nblk, k0 = 64 * kb, n0 = 64 * nb;
    const int n4 = lane & 15, sub = lane >> 4;
#pragma unroll
    for (int i = 0; i < 16; ++i) { const int kl = 4 * i + sub; LAS float* p = scr + (4 * n4) * 65 + kl; p[0] = v[i].x * gv[i]; p[65] = v[i].y * gv[i]; p[130] = v[i].z * gv[i]; p[195] = v[i].w * gv[i]; }
    LDS_WAIT();
    const int c = lane & 7;
#pragma unroll
    for (int j = 0; j < 8; ++j) { const int nl = (lane >> 3) + 8 * j, nn = n0 + nl;
        if (nn < d.N) { int dr = nn; if (d.mode == 1) dr = (nn < 1280) ? nn : (nn < 1288 ? 2816 + (nn - 1280) : nn - 8);
            const LAS float* sp = scr + nl * 65 + 8 * c;
            u32x4 o; o.x = pk2(sp[0], sp[1]); o.y = pk2(sp[2], sp[3]); o.z = pk2(sp[4], sp[5]); o.w = pk2(sp[6], sp[7]);
            *(GAS u32x4*)(d.WT + (size_t)dr * d.K + k0 + 8 * c) = o; } }
    LDS_WAIT();
}
DI float row_to_bf16(const float* xrow, bf16_t* orow, int lane) {
    const f32x4* xr = (const f32x4*)xrow + lane; f32x4 v[4]; float s = 0.f;
#pragma unroll
    for (int j = 0; j < 4; ++j) { v[j] = xr[64 * j]; s += (v[j].x * v[j].x + v[j].y * v[j].y) + (v[j].z * v[j].z + v[j].w * v[j].w); }
    u32x2* o8 = (u32x2*)orow + lane;
#pragma unroll
    for (int j = 0; j < 4; ++j) { u32x2 w; w.x = pk2(v[j].x, v[j].y); w.y = pk2(v[j].z, v[j].w); o8[64 * j] = w; }
    return wave_sum(s);
}

constexpr int I_IN = 16 * 45, I_OUT = 16 * 16, I_XQ = 16 * 8, I_XO = 8 * 16, I_F1 = 16 * 64, I_F2 = 64 * 16;
constexpr int Q_OUT = I_IN, Q_XQ = Q_OUT + I_OUT, Q_XK = Q_XQ + I_XQ, Q_XO = Q_XK + 2 * I_XQ, Q_F1 = Q_XO + I_XO, Q_F2 = Q_F1 + I_F1, I_L = Q_F2 + I_F2;
DI TDesc get_desc(const Params& P, unsigned char* ws, int l, int q) {
    unsigned char* wl = ws + WS_W + (size_t)l * WL_SZ; bf16_t* WMEM = (bf16_t*)(ws + WS_WMEM);
    TDesc d; d.K = DM; d.g1 = P.final_g; d.g2 = P.final_g; d.gsplit = 1 << 30; d.mode = 0;
    if (q < I_IN) { d.W = P.w_in + (size_t)l * DM * IN_DIM; d.N = IN_DIM; d.WT = (bf16_t*)(wl + WL_IN); d.g1 = P.norm_mix_g + l * DM; d.mode = 1; }
    else if ((q -= I_IN) < I_OUT) { d.W = P.w_out + (size_t)l * DM * DM; d.N = DM; d.WT = (bf16_t*)(wl + WL_OUT); d.g1 = P.ssd_norm_g + l * 512; d.g2 = P.sb_norm_g + l * 512; d.gsplit = 512; }
    else if ((q -= I_OUT) < I_XQ) { d.W = P.w_xq + (size_t)l * DM * 512; d.N = 512; d.WT = (bf16_t*)(wl + WL_XQ); d.g1 = P.norm_xa_g + l * DM; }
    else if ((q -= I_XQ) < I_XQ) { d.W = P.w_xk + (size_t)l * DM * 512; d.N = 512; d.WT = WMEM + (size_t)(l * 1024) * DM; d.g1 = P.norm_mem_g + l * DM; }
    else if ((q -= I_XQ) < I_XQ) { d.W = P.w_xv + (size_t)l * DM * 512; d.N = 512; d.WT = WMEM + (size_t)(l * 1024 + 512) * DM; d.g1 = P.norm_mem_g + l * DM; }
    else if ((q -= I_XQ) < I_XO) { d.W = P.w_xo + (size_t)l * 512 * DM; d.K = 512; d.N = DM; d.WT = (bf16_t*)(wl + WL_XO); d.mode = 2; }
    else if ((q -= I_XO) < I_F1) { d.W = P.w_ff1 + (size_t)l * DM * DFF; d.N = DFF; d.WT = (bf16_t*)(wl + WL_FF1); d.g1 = P.norm_ff_g + l * DM; }
    else { q -= I_F1; d.W = P.w_ff2 + (size_t)l * DFF * DM; d.K = DFF; d.N = DM; d.WT = (bf16_t*)(wl + WL_FF2); d.mode = 2; }
    d.item = q; return d;
}
DI void convert_items(const Params& P, unsigned char* ws, int l, int q_lo, int q_hi, int gw, int NGW, LAS float* scr, int lane) {
    int it = q_lo + gw; if (it >= q_hi) return;
    TDesc dc = get_desc(P, ws, l, it); f32x4 vc[16]; float gc[16]; tr_load(dc, lane, vc, gc);
    for (;;) {
        const int nx = it + NGW; const bool has = nx < q_hi;
        TDesc dn = dc; f32x4 vn[16]; float gn[16];
#pragma unroll
        for (int i = 0; i < 16; ++i) { vn[i] = vc[i]; gn[i] = gc[i]; }
        if (has) { dn = get_desc(P, ws, l, nx); tr_load(dn, lane, vn, gn); }
        tr_finish(dc, lane, vc, gc, scr);
        if (!has) break;
        dc = dn; it = nx;
#pragma unroll
        for (int i = 0; i < 16; ++i) { vc[i] = vn[i]; gc[i] = gn[i]; }
    }
}

__global__ void __launch_bounds__(512, 2) fwd_kernel(Params P) {
    extern __shared__ __attribute__((aligned(16))) unsigned char lds_raw[];
    LAS unsigned char* lds = (LAS unsigned char*)lds_raw;
    cg::grid_group grid = cg::this_grid();
    if (P.ph_hi == 12345) grid.sync();
    volatile LAS unsigned* xst = (volatile LAS unsigned*)(lds + 147200);
    if (threadIdx.x < 64) xst[threadIdx.x] = 0u;
    __syncthreads();
    const XcdBarrier xbar = xcd_barrier_post((unsigned*)P.ws + 4096, xst);
    const int lo = P.ph_lo, hi_ph = P.ph_hi - ((gridDim.x == 256) ? 1 : 0);
    int ph = 0;
    int layer = 0;
#ifdef TS_LO
#define TS_STAMP() do { if (blockIdx.x == 0 && threadIdx.x == 0) ((unsigned long long*)P.ws)[ph] = __builtin_amdgcn_s_memrealtime(); } while (0)
#else
#define TS_STAMP() do {} while (0)
#endif
#ifndef RP
#define RP -1
#endif
#define PHASE_BEGIN TS_STAMP(); if (ph >= lo && ph < hi_ph) { for (int rep_ = 0; rep_ < ((ph == RP) ? 2 : 1); ++rep_) { \
    int tid = threadIdx.x; asm volatile("" : "+v"(tid)); int bx = blockIdx.x; asm volatile("" : "+s"(bx)); unsigned char* ws = P.ws; asm volatile("" : "+s"(ws)); \
    const int lane = tid & 63, wave = __builtin_amdgcn_readfirstlane(tid >> 6), G = gridDim.x, vcu = (G % 8 == 0) ? (bx % 8) * (G / 8) + bx / 8 : bx, r = lane & 31, hi = lane >> 5; \
    bf16_t* HB = (bf16_t*)(ws + WS_HB); bf16_t* XST = (bf16_t*)P.out; bf16_t* BC = (bf16_t*)P.out + (size_t)8 * 1024 * 1024; bf16_t* PSF = (bf16_t*)P.out + (size_t)16 * 1024 * 1024; (void)PSF; \
    bf16_t* U = (bf16_t*)(ws + WS_U); bf16_t* PJ = (bf16_t*)(ws + WS_PJ); bf16_t* VT = (bf16_t*)(ws + WS_VT); bf16_t* YALL = (bf16_t*)(ws + WS_YALL); \
    bf16_t* XQ = (bf16_t*)(ws + WS_XQ); bf16_t* XAO = (bf16_t*)(ws + WS_XAO); \
    float* ST = (float*)(ws + WS_ST); bf16_t* MK = (bf16_t*)(ws + WS_MK); bf16_t* MVT = (bf16_t*)(ws + WS_MVT); \
    float* SS = (float*)(ws + WS_SS); float* DT = (float*)(ws + WS_DT); float* ACUM = (float*)(ws + WS_ACUM); float* DTRAW = (float*)(ws + WS_DTRAW); \
    bf16_t* MEMB = (bf16_t*)(ws + WS_MEMB); float* RMEM = (float*)(ws + WS_RMEM); bf16_t* WMEM = (bf16_t*)(ws + WS_WMEM); \
    unsigned char* wl = ws + WS_W + (size_t)layer * WL_SZ; \
    (void)lane; (void)wave; (void)vcu; (void)r; (void)hi; (void)HB; (void)XST; (void)BC; (void)U; (void)PJ; (void)VT; (void)YALL; (void)XQ; (void)XAO; (void)ST; (void)MK; (void)MVT; \
    (void)SS; (void)DT; (void)ACUM; (void)DTRAW; (void)MEMB; (void)RMEM; (void)WMEM; (void)wl;
#define PHASE_END   } if (ph + 1 < hi_ph) xcd_barrier(xbar); } ++ph;

    PHASE_BEGIN
    {
        LAS float* scr = (LAS float*)(lds + wave * 16896);
        const int gw = vcu * 8 + wave, NGW = G * 8;
        convert_items(P, ws, 0, 0, Q_F1, gw, NGW, scr, lane); convert_items(P, ws, 1, Q_XK, Q_XO, gw, NGW, scr, lane);
        for (int i = bx * 512 + tid; i < 2 * 248 * 128; i += G * 512) { const int l = i / (248 * 128), q = i % (248 * 128);
            *(u32x4*)((bf16_t*)(ws + WS_W + (size_t)l * WL_SZ + WL_IN) + (size_t)(2824 + q / 128) * DM + (q % 128) * 8) = (u32x4){0u, 0u, 0u, 0u}; }
        for (int m = gw * 8; m < M; m += NGW * 8) {
            f32x4 v[8][4];
#pragma unroll
            for (int q = 0; q < 8; ++q)
#pragma unroll
                for (int j = 0; j < 4; ++j) v[q][j] = __builtin_nontemporal_load((const GAS f32x4*)(P.x + (size_t)(m + q) * DM) + lane + 64 * j);
#pragma unroll
            for (int q = 0; q < 8; ++q) { float sq = 0.f; GAS u32x2* o8 = (GAS u32x2*)(HB + (size_t)(m + q) * DM) + lane;
#pragma unroll
                for (int j = 0; j < 4; ++j) { const f32x4 t = v[q][j]; sq += (t.x * t.x + t.y * t.y) + (t.z * t.z + t.w * t.w); u32x2 w; w.x = pk2(t.x, t.y); w.y = pk2(t.z, t.w); o8[64 * j] = w; }
                sq = wave_sum(sq);
                if (lane < 16) SS[(size_t)(m + q) * 16 + lane] = (lane == 0) ? sq : 0.f; }
        }
        for (int m = gw; m < NB * MEML; m += NGW) { const float s = row_to_bf16(P.mem + (size_t)m * DM, MEMB + (size_t)m * DM, lane);
            if (lane == 0) RMEM[m] = __builtin_amdgcn_rsqf(s * (1.0f / 1024.0f) + EPS); }
    }
    PHASE_END

    for (layer = 0; layer < 2; ++layer) {
        PHASE_BEGIN
        {
            pg8::Gemm g{HB, (const bf16_t*)(wl + WL_IN), M, NPROJ, DM}; pg8::StaticOrder S; S.init(M, NPROJ, G, bx);
            LAS float* rsl = (LAS float*)(lds + 131072);
            { Unit uu; for (int i = 0; i < 15 && S.next(i, uu); ++i) if (tid < 256) rsl[i * 256 + tid] = row_rs(SS, uu.pm * 256 + tid); }
            __syncthreads();
            EpiProj E{PJ, (bf16_t*)(ws + WS_QF), (bf16_t*)(ws + WS_KF), VT, DTRAW, rsl};
            pg8::gemm_phase<EpiProj, pg8::StaticOrder, true, true>(lds, g, S, E, tid);
        }
        PHASE_END

        PHASE_BEGIN
        {
            LAS float* scl = (LAS float*)lds;
            LAS bf16_t* XT = (LAS bf16_t*)(lds + 4096);
            constexpr int LP = 136;
            for (int u = vcu; u < 256; u += G) {
                const int b = u >> 6, c = (u >> 1) & 31, g = u & 1; const size_t rowc = (size_t)b * SEQ + c * 128;
                if (wave < 4) {
                    const int h = 4 * g + wave, t0 = 2 * lane;
                    const float dtb = P.dt_bias[layer * 8 + h], A = -fexp(P.a_log[layer * 8 + h]);
                    const float x0 = DTRAW[(rowc + t0) * 8 + h] + dtb, x1 = DTRAW[(rowc + t0 + 1) * 8 + h] + dtb;
                    const float d0 = __builtin_fmaxf(x0, 0.f) + flog1p(fexp(-__builtin_fabsf(x0))), d1 = __builtin_fmaxf(x1, 0.f) + flog1p(fexp(-__builtin_fabsf(x1)));
                    const float a0 = d0 * A, a1 = d1 * A, pair = a0 + a1; float incl = pair;
#pragma unroll
                    for (int o = 1; o < 64; o <<= 1) { const float t = __shfl_up(incl, o); if (lane >= o) incl += t; }
                    const float excl = incl - pair, ac0 = excl + a0, ac1 = incl, last = __shfl(incl, 63);
                    DT[(rowc + t0) * 8 + h] = d0; DT[(rowc + t0 + 1) * 8 + h] = d1; ACUM[(rowc + t0) * 8 + h] = ac0; ACUM[(rowc + t0 + 1) * 8 + h] = ac1;
                    scl[wave * 128 + t0] = d0 * fexp(last - ac0); scl[wave * 128 + t0 + 1] = d1 * fexp(last - ac1);
                }
                __syncthreads();
                for (int it = tid; it < 48 * 16; it += 512) {
                    const int cgp = it % 48, l0 = (it / 48) * 8;
                    const int pjcol = cgp < 32 ? 512 + g * 256 + cgp * 8 : (cgp < 40 ? 1024 + g * 64 + (cgp - 32) * 8 : 1152 + g * 64 + (cgp - 40) * 8);
                    const int cc = pjcol - 512;
                    u32x4 raw[11];
#pragma unroll
                    for (int j = 0; j < 11; ++j) { const int pos = c * 128 + l0 - 3 + j;
                        raw[j] = pos >= 0 ? __builtin_nontemporal_load((const GAS u32x4*)(PJ + (size_t)(rowc + l0 - 3 + j) * PJW + pjcol)) : (u32x4){0u, 0u, 0u, 0u}; }
                    const float* cw = P.conv_w + (size_t)layer * 4 * 768 + cc; const float* cbp = P.conv_b + (size_t)layer * 768 + cc;
                    float o[8][8];
#pragma unroll
                    for (int j8 = 0; j8 < 8; ++j8) {
                        const float w0 = cw[j8], w1 = cw[768 + j8], w2 = cw[2 * 768 + j8], w3 = cw[3 * 768 + j8], bb = cbp[j8];
                        float xv[11];
#pragma unroll
                        for (int j = 0; j < 11; ++j) { const unsigned wd = raw[j][j8 >> 1]; xv[j] = __uint_as_float((j8 & 1) ? (wd & 0xffff0000u) : (wd << 16)); }
#pragma unroll
                        for (int t = 0; t < 8; ++t) { const float v = bb + w0 * xv[t] + w1 * xv[t + 1] + w2 * xv[t + 2] + w3 * xv[t + 3]; o[j8][t] = v * __builtin_amdgcn_rcpf(1.f + fexp(-v)); }
                    }
                    if (cgp < 32) {
#pragma unroll
                        for (int j8 = 0; j8 < 8; ++j8) { const int chl = cgp * 8 + j8, e = chl >> 6, p = chl & 63, h = 4 * g + e;
                            *(GAS bf16x8*)(XST + ((size_t)(((((b * 8 + h) * 32 + c) * 4 + (l0 >> 5)) * 2 + (p >> 5)) * 2 + ((l0 >> 3) & 1))) * 512 + (((l0 >> 4) & 1) * 32 + (p & 31)) * 8) = pack8(o[j8][0], o[j8][1], o[j8][2], o[j8][3], o[j8][4], o[j8][5], o[j8][6], o[j8][7]);
                            const LAS float* sc = scl + e * 128 + l0;
                            *(LAS bf16x8*)(XT + chl * LP + l0) = pack8(o[j8][0] * sc[0], o[j8][1] * sc[1], o[j8][2] * sc[2], o[j8][3] * sc[3], o[j8][4] * sc[4], o[j8][5] * sc[5], o[j8][6] * sc[6], o[j8][7] * sc[7]); }
                    } else {
                        const bool isB = cgp < 40; const int n0 = (isB ? cgp - 32 : cgp - 40) * 8;
                        bf16_t* fb = BC + (isB ? 0 : (size_t)4 * 1024 * 1024) + ((size_t)((((b * 32 + c) * 2 + g) * 4) * 4 + (n0 >> 4))) * 512 + ((n0 >> 3) & 1) * 256;
#pragma unroll
                        for (int t = 0; t < 8; ++t) { const int l = l0 + t;
                            *(GAS bf16x8*)(fb + (size_t)(l >> 5) * 2048 + (isB ? pi_inv(l & 31) : (l & 31)) * 8) = pack8(o[0][t], o[1][t], o[2][t], o[3][t], o[4][t], o[5][t], o[6][t], o[7][t]); }
                        if (cgp < 40) {
#pragma unroll
                            for (int j8 = 0; j8 < 8; ++j8) *(LAS bf16x8*)(XT + (256 + (cgp - 32) * 8 + j8) * LP + l0) = pack8(o[j8][0], o[j8][1], o[j8][2], o[j8][3], o[j8][4], o[j8][5], o[j8][6], o[j8][7]);
                        }
                    }
                }
                __syncthreads();
                {
                    const int e = wave >> 1, phf = wave & 1, h = 4 * g + e;
                    f32x16 a0 = {}, a1 = {};
#pragma unroll
                    for (int s = 0; s < 8; ++s) {
                        const bf16x8 af = *(const LAS bf16x8*)(XT + (e * 64 + phf * 32 + r) * LP + 16 * s + 8 * hi);
                        const bf16x8 b0 = *(const LAS bf16x8*)(XT + (256 + r) * LP + 16 * s + 8 * hi);
                        const bf16x8 b1 = *(const LAS bf16x8*)(XT + (256 + 32 + r) * LP + 16 * s + 8 * hi);
                        a0 = MFMA32(af, b0, a0); a1 = MFMA32(af, b1, a1);
                    }
                    float* dst = ST + ((size_t)((b * 32 + c) * 8 + h)) * 4096;
#pragma unroll
                    for (int i = 0; i < 16; ++i) { const int p = phf * 32 + crow(i, hi); dst[p * 64 + r] = a0[i]; dst[p * 64 + 32 + r] = a1[i]; }
                }
                __syncthreads();
            }
        }
        PHASE_END

        PHASE_BEGIN
        {
            if (rep_ == 0) for (int e = bx * 512 + tid; e < NB * 8 * 4096; e += G * 512) {
                const int b = e >> 15, h = (e >> 12) & 7, pn = e & 4095; float run = 0.f;
                float sv[32], dec[32];
#pragma unroll
                for (int j = 0; j < 32; ++j) { sv[j] = __builtin_nontemporal_load((const GAS float*)(ST + ((size_t)((b * 32 + j) * 8 + h)) * 4096 + pn)); dec[j] = ACUM[((size_t)b * SEQ + j * 128 + 127) * 8 + h]; }
                const int p = pn >> 6, n = pn & 63;
                bf16_t* pd = PSF + ((size_t)(((b * 32) * 8 + h) * 2 + (p >> 5)) * 4 + (n >> 4)) * 512 + (((n >> 3) & 1) * 32 + (p & 31)) * 8 + (n & 7);
#pragma unroll
                for (int j = 0; j < 32; ++j) { stg2(pd + (size_t)j * 8 * 2 * 4 * 512, f2bf(run)); run = run * fexp(dec[j]) + sv[j]; }
            }
            LAS float* part = (LAS float*)lds;
            const int h = wave;
            for (int u = vcu; u < 512; u += G) {
                const int b = u >> 7, qb = 127 - (u & 127); const size_t rowbase = (size_t)b * SEQ; const int q0 = qb * 32;
                bf16x8 qf[4];
#pragma unroll
                for (int s = 0; s < 4; ++s) qf[s] = ldg8((const bf16_t*)(ws + WS_QF) + ((size_t)(((b * 8 + h) * 128 + qb) * 4 + s)) * 512 + lane * 8);
                f32x16 o0 = {}, o1 = {}; float R = 0.f;
                const bf16_t* Kb = (const bf16_t*)(ws + WS_KF) + ((size_t)((b * 8 + h) * 128)) * 2048 + lane * 8;
                const bf16_t* Vb = VT + ((size_t)((b * 8 + h) * 128)) * 2048 + lane * 8;
                bf16x8 kf[4];
#pragma unroll
                for (int s4 = 0; s4 < 4; ++s4) kf[s4] = ldg8(Kb + (size_t)qb * 2048 + s4 * 512);
                for (int kt = qb; kt >= 0; --kt) {
                    bf16x8 vf[2][2];
#pragma unroll
                    for (int d = 0; d < 2; ++d)
#pragma unroll
                        for (int j = 0; j < 2; ++j) vf[d][j] = ldg8(Vb + (size_t)kt * 2048 + (d * 2 + j) * 512);
                    f32x16 st = {};
#pragma unroll
                    for (int s4 = 0; s4 < 4; ++s4) st = MFMA32(kf[s4], qf[s4], st);
                    {   const int kn = kt > 0 ? kt - 1 : 0;
#pragma unroll
                        for (int s4 = 0; s4 < 4; ++s4) kf[s4] = ldg8(Kb + (size_t)kn * 2048 + s4 * 512); }
                    float w[16]; float suf = 0.f;
                    if (kt == qb) {
#pragma unroll
                        for (int i = 0; i < 16; ++i) if (16 * hi + i >= r) st[i] = -INFINITY;
                    }
#pragma unroll
                    for (int i = 15; i >= 0; --i) {
                        const float z = st[i] * 0.125f; const float sp = __builtin_fmaxf(z, 0.f) + flog(1.f + fexp(-__builtin_fabsf(z)));
                        w[i] = (z - sp) + suf; suf -= sp;
                    }
                    const float other = __shfl_xor(suf, 32);
                    const float add = R + (hi == 0 ? other : 0.f);
#pragma unroll
                    for (int i = 0; i < 16; ++i) w[i] = fexp(w[i] + add);
                    R += suf + other;
                    const bf16x8 pa0 = pack8(w[0], w[1], w[2], w[3], w[4], w[5], w[6], w[7]), pa1 = pack8(w[8], w[9], w[10], w[11], w[12], w[13], w[14], w[15]);
                    o0 = MFMA32(vf[0][0], pa0, o0); o0 = MFMA32(vf[0][1], pa1, o0); o1 = MFMA32(vf[1][0], pa0, o1); o1 = MFMA32(vf[1][1], pa1, o1);
                    if (__all(R < -88.f)) break;
                }
                float ssq = 0.f;
#pragma unroll
                for (int i = 0; i < 16; ++i) ssq += o0[i] * o0[i] + o1[i] * o1[i];
                ssq += __shfl_xor(ssq, 32);
                if (hi == 0) part[r * 8 + h] = ssq;
                __syncthreads();
                {
                    const f32x4 a = *(const LAS f32x4*)(part + r * 8), c4 = *(const LAS f32x4*)(part + r * 8 + 4);
                    const float sm = ((a.x + a.y) + (a.z + a.w)) + ((c4.x + c4.y) + (c4.z + c4.w)); const float rinv = __builtin_amdgcn_rsqf(sm * (1.0f / 512.0f) + EPS);
                    bf16_t* yp = YALL + (rowbase + q0 + r) * DM + 512 + h * 64;
                    store_row32(yp, o0, rinv, hi); store_row32(yp + 32, o1, rinv, hi);
                }
                __syncthreads();
            }
        }
        PHASE_END

        PHASE_BEGIN
        {
            LAS float* acT = (LAS float*)lds;
            LAS float* dtT = (LAS float*)(lds + 4096);
            LAS float* part = (LAS float*)(lds + 8192);
            const int h = wave, g = h >> 2;
            for (int u = vcu; u < 256; u += G) {
                const int b = u >> 6, c = (u >> 1) & 31, lh = u & 1; const size_t rowc = (size_t)b * SEQ + c * 128;
                for (int e = tid; e < 1024; e += 512) { const int l = e >> 3, hh = e & 7; acT[hh * 128 + l] = ACUM[(rowc + l) * 8 + hh]; dtT[hh * 128 + l] = DT[(rowc + l) * 8 + hh]; }
                bf16x8 pf[2][4];
                {
#pragma unroll
                    for (int pt = 0; pt < 2; ++pt)
#pragma unroll
                        for (int k = 0; k < 4; ++k) pf[pt][k] = ldg8(PSF + ((size_t)((((b * 32 + c) * 8 + h) * 2 + pt) * 4 + k)) * 512 + lane * 8);
                }
                const float dsk = P.d_skip[layer * 8 + h];
                __syncthreads();
                for (int lbi = 0; lbi < 2; ++lbi) {
                    const int lb = lh ? (1 + lbi) : (3 * lbi), l0 = lb * 32;
                    bf16x8 cf[4];
#pragma unroll
                    for (int k = 0; k < 4; ++k) cf[k] = ldg8(BC + (size_t)4 * 1024 * 1024 + ((size_t)((((b * 32 + c) * 2 + g) * 4 + lb) * 4 + k)) * 512 + lane * 8);
                    f32x16 o0 = {}, o1 = {};
#pragma unroll
                    for (int k = 0; k < 4; ++k) { o0 = MFMA32(pf[0][k], cf[k], o0); o1 = MFMA32(pf[1][k], cf[k], o1); }
                    const float a_l = acT[h * 128 + l0 + r];
                    { const float e = fexp(a_l); o0 *= e; o1 *= e; }
                    for (int sb = 0; sb <= lb; ++sb) {
                        const int s0 = sb * 32;
                        bf16x8 bfr[4], vf[2][2];
#pragma unroll
                        for (int k = 0; k < 4; ++k) bfr[k] = ldg8(BC + ((size_t)((((b * 32 + c) * 2 + g) * 4 + sb) * 4 + k)) * 512 + lane * 8);
#pragma unroll
                        for (int pt = 0; pt < 2; ++pt)
#pragma unroll
                            for (int j = 0; j < 2; ++j) vf[pt][j] = ldg8(XST + ((size_t)(((((b * 8 + h) * 32 + c) * 4 + sb) * 2 + pt) * 2 + j)) * 512 + lane * 8);
                        f32x16 st = {};
#pragma unroll
                        for (int k = 0; k < 4; ++k) st = MFMA32(bfr[k], cf[k], st);
                        float w[16]; const bool diag = (sb == lb);
#pragma unroll
                        for (int q4 = 0; q4 < 4; ++q4) {
                            const f32x4 as = *(const LAS f32x4*)(acT + h * 128 + s0 + 16 * hi + 4 * q4), ds = *(const LAS f32x4*)(dtT + h * 128 + s0 + 16 * hi + 4 * q4);
#pragma unroll
                            for (int e = 0; e < 4; ++e) { const int i = 4 * q4 + e; float p = st[i] * fexp(a_l - as[e]) * ds[e];
                                if (diag) { const int sl = 16 * hi + i; if (sl > r) p = 0.f; if (sl == r) p += dsk; }
                                w[i] = p; }
                        }
                        const bf16x8 pa0 = pack8(w[0], w[1], w[2], w[3], w[4], w[5], w[6], w[7]), pa1 = pack8(w[8], w[9], w[10], w[11], w[12], w[13], w[14], w[15]);
                        o0 = MFMA32(vf[0][0], pa0, o0); o0 = MFMA32(vf[0][1], pa1, o0); o1 = MFMA32(vf[1][0], pa0, o1); o1 = MFMA32(vf[1][1], pa1, o1);
                    }
                    float ssq = 0.f;
                    {
                        const bf16_t* zp = PJ + (rowc + l0 + r) * PJW + h * 64 + 4 * hi;
                        u32x2 zv[2][4];
#pragma unroll
                        for (int pt = 0; pt < 2; ++pt)
#pragma unroll
                            for (int g4 = 0; g4 < 4; ++g4) zv[pt][g4] = *(const GAS u32x2*)(zp + pt * 32 + 8 * g4);
#pragma unroll
                        for (int g4 = 0; g4 < 4; ++g4)
#pragma unroll
                            for (int e = 0; e < 4; ++e) {
                                const unsigned w0 = zv[0][g4][e >> 1], w1 = zv[1][g4][e >> 1];
                                const float z0 = __uint_as_float((e & 1) ? (w0 & 0xffff0000u) : (w0 << 16)), z1 = __uint_as_float((e & 1) ? (w1 & 0xffff0000u) : (w1 << 16));
                                const int i = 4 * g4 + e;
                                o0[i] *= z0 * __builtin_amdgcn_rcpf(1.f + fexp(-z0)); o1[i] *= z1 * __builtin_amdgcn_rcpf(1.f + fexp(-z1));
                                ssq += o0[i] * o0[i] + o1[i] * o1[i];
                            }
                    }
                    ssq += __shfl_xor(ssq, 32);
                    LAS float* pp = part + lbi * 256;
                    if (hi == 0) pp[r * 8 + h] = ssq;
                    __syncthreads();
                    {
                        const f32x4 a = *(const LAS f32x4*)(pp + r * 8), c4 = *(const LAS f32x4*)(pp + r * 8 + 4);
                        const float sm = ((a.x + a.y) + (a.z + a.w)) + ((c4.x + c4.y) + (c4.z + c4.w)); const float rinv = __builtin_amdgcn_rsqf(sm * (1.0f / 512.0f) + EPS);
                        bf16_t* yp = YALL + (rowc + l0 + r) * DM + h * 64;
                        store_row32(yp, o0, rinv, hi); store_row32(yp + 32, o1, rinv, hi);
                    }
                }
                __syncthreads();
            }
        }
        PHASE_END

        PHASE_BEGIN
        {
            pg8::Gemm g{YALL, (const bf16_t*)(wl + WL_OUT), M, DM, DM}; pg8::StaticOrder S; S.init(M, DM, G, bx);
            EpiResid E{HB, SS};
            pg8::gemm_phase<EpiResid, pg8::StaticOrder, true, true>(lds, g, S, E, tid);
        }
        PHASE_END

        PHASE_BEGIN
        {
            const bool split = (layer == 0 && G >= 160);
            if (layer == 0 && (!split || (bx >= 128 && bx < 160))) {
                pg8::Gemm g{MEMB, WMEM, NB * MEML, 2048, DM}; pg8::StaticOrder S; S.init(NB * MEML, 2048, split ? 32 : G, split ? bx - 128 : bx);
                EpiMem E{MK, MVT, RMEM};
                pg8::gemm_phase<EpiMem, pg8::StaticOrder, false, true>(lds, g, S, E, tid);
            }
            if (!split || bx < 128) {
                pg8::Gemm g{HB, (const bf16_t*)(wl + WL_XQ), M, 512, DM}; pg8::StaticOrder S; S.init(M, 512, split ? 128 : G, bx);
                LAS float* rsl = (LAS float*)(lds + 131072);
                { Unit uu; for (int i = 0; i < 15 && S.next(i, uu); ++i) if (tid < 256) rsl[i * 256 + tid] = row_rs(SS, uu.pm * 256 + tid) * 0.08838834764831845f; }
                __syncthreads();
                EpiScale<0> E{XQ, 512, rsl};
                pg8::gemm_phase<EpiScale<0>, pg8::StaticOrder, true, true>(lds, g, S, E, tid);
            }
            {
                const bool big = G >= 160; const int first = layer == 0 ? 160 : 128;
                if (!big || bx >= first) {
                    LAS float* scr = (LAS float*)(lds + wave * 16896); const int gw = (big ? bx - first : bx) * 8 + wave, NGW = (big ? G - first : G) * 8;
                    const int nr = layer == 0 ? 3 : 1;
                    for (int k = 0; k < nr; ++k) {
                        const int l_ = (layer == 0 && k == 0) ? 0 : 1;
                        const int lo_ = layer == 0 ? (k == 0 ? Q_F1 : (k == 1 ? 0 : Q_XO)) : Q_F1;
                        const int hi_ = layer == 0 ? (k == 0 ? I_L : (k == 1 ? Q_XK : Q_F1)) : I_L;
                        convert_items(P, ws, l_, lo_, hi_, gw, NGW, scr, lane);
                    }
                }
            }
        }
        PHASE_END

        PHASE_BEGIN
        {
            const int h = wave & 3, sub = wave >> 2;
            for (int u = vcu; u < 256; u += G) {
                const int b = u >> 6; const size_t row0 = (size_t)u * 64 + sub * 32;
                bf16x8 qf[8];
#pragma unroll
                for (int k = 0; k < 8; ++k) qf[k] = ldg8(XQ + ((size_t)(((row0 >> 5) * 4 + h) * 8 + k)) * 512 + lane * 8);
                const bf16_t* Kh = MK + ((size_t)((layer * 4 + b) * 4 + h)) * 32768 + lane * 8;
                const bf16_t* Vh = MVT + ((size_t)((layer * 4 + b) * 4 + h)) * 32768 + lane * 8;
                float mx = -INFINITY;
                bf16x8 kf[8];
                {
#pragma unroll
                    for (int k = 0; k < 8; ++k) kf[k] = ldg8(Kh + k * 512); }
                f32x16 o[4] = {{}, {}, {}, {}}; float lsum = 0.f;
#pragma unroll 1
                for (int kt = 0; kt < 8; ++kt) {
                    bf16x8 vf[4][2];
#pragma unroll
                    for (int d = 0; d < 4; ++d) { vf[d][0] = ldg8(Vh + (size_t)kt * 4096 + (d * 2) * 512); vf[d][1] = ldg8(Vh + (size_t)kt * 4096 + (d * 2 + 1) * 512); }
                    f32x16 st = {};
#pragma unroll
                    for (int k = 0; k < 8; ++k) st = MFMA32(kf[k], qf[k], st);
                    {   const bf16_t* kp = Kh + (size_t)((kt + 1) & 7) * 4096;
#pragma unroll
                        for (int k = 0; k < 8; ++k) kf[k] = ldg8(kp + k * 512); }
                    float tm = st[0];
#pragma unroll
                    for (int i = 1; i < 16; ++i) tm = __builtin_fmaxf(tm, st[i]);
                    tm = __builtin_fmaxf(tm, __shfl_xor(tm, 32));
                    const float mn = __builtin_fmaxf(mx, tm), f = fexp(mx - mn);
                    mx = mn; lsum *= f;
#pragma unroll
                    for (int d = 0; d < 4; ++d) o[d] *= f;
                    float w[16];
#pragma unroll
                    for (int i = 0; i < 16; ++i) { w[i] = fexp(st[i] - mn); lsum += w[i]; }
                    const bf16x8 pa0 = pack8(w[0], w[1], w[2], w[3], w[4], w[5], w[6], w[7]), pa1 = pack8(w[8], w[9], w[10], w[11], w[12], w[13], w[14], w[15]);
#pragma unroll
                    for (int d = 0; d < 4; ++d) { o[d] = MFMA32(vf[d][0], pa0, o[d]); o[d] = MFMA32(vf[d][1], pa1, o[d]); }
                }
                lsum += __shfl_xor(lsum, 32);
                {
                    const float li = __builtin_amdgcn_rcpf(lsum); bf16_t* op = XAO + (row0 + r) * 512 + h * 128;
#pragma unroll
                    for (int d = 0; d < 4; ++d) store_row32(op + d * 32, o[d], li, hi);
                }
            }
        }
        PHASE_END

        PHASE_BEGIN
        {
            pg8::Gemm g{XAO, (const bf16_t*)(wl + WL_XO), M, DM, 512}; pg8::StaticOrder S; S.init(M, DM, G, bx);
            EpiResid E{HB, SS};
            pg8::gemm_phase<EpiResid, pg8::StaticOrder, true, true>(lds, g, S, E, tid);
        }
        PHASE_END

        PHASE_BEGIN
        {
            pg8::Gemm g{HB, (const bf16_t*)(wl + WL_FF1), M, DFF, DM}; pg8::StaticOrder S; S.init(M, DFF, G, bx);
            LAS float* rsl = (LAS float*)(lds + 131072);
            { Unit uu; for (int i = 0; i < 15 && S.next(i, uu); ++i) if (tid < 256) rsl[i * 256 + tid] = row_rs(SS, uu.pm * 256 + tid); }
            __syncthreads();
            EpiScale<1> E{U, DFF, rsl};
            pg8::gemm_phase<EpiScale<1>, pg8::StaticOrder, true, true>(lds, g, S, E, tid);
        }
        PHASE_END

        PHASE_BEGIN
        {
            pg8::Gemm g{U, (const bf16_t*)(wl + WL_FF2), M, DM, DFF}; pg8::StaticOrder S; S.init(M, DM, G, bx);
            if (layer == 1 && G == 256) {
                EpiFinal E{HB, P.out, P.final_g, (float*)(ws + 244 * MiB), (unsigned*)ws + 8192};
                pg8::gemm_phase<EpiFinal, pg8::StaticOrder, false, true>(lds + 0, g, S, E, tid);
            } else {
                EpiResid E{HB, SS};
                pg8::gemm_phase<EpiResid, pg8::StaticOrder, true, true>(lds, g, S, E, tid);
            }
        }
        PHASE_END
    }

    PHASE_BEGIN
    {
        const int gw = vcu * 8 + wave, NGW = G * 8;
        for (int m = gw; m < M; m += NGW) {
            const float rs = row_rs(SS, m);
            const u32x2* hp = (const u32x2*)(HB + (size_t)m * DM) + lane; f32x4* op = (f32x4*)(P.out + (size_t)m * DM) + lane; const f32x4* gp = (const f32x4*)P.final_g + lane;
#pragma unroll
            for (int j = 0; j < 4; ++j) { const u32x2 hv = hp[64 * j]; const f32x4 gg = gp[64 * j];
                f32x4 v; v.x = __uint_as_float(hv.x << 16); v.y = __uint_as_float(hv.x & 0xffff0000u); v.z = __uint_as_float(hv.y << 16); v.w = __uint_as_float(hv.y & 0xffff0000u);
                op[64 * j] = v * rs * gg; }
        }
    }
    } }
#ifdef EXTRA_SYNCS
    for (int i_ = 0; i_ < EXTRA_SYNCS; ++i_) xcd_barrier(xbar);
#endif
    ++ph;
#ifdef TS_LO
    xcd_barrier(xbar);
    TS_STAMP();
    xcd_barrier(xbar);
    {
        const unsigned long long* ts = (const unsigned long long*)P.ws; const long long K = (long long)(ts[TS_HI] - ts[TS_LO]) * 10;
        for (long long i = (long long)blockIdx.x * 512 + threadIdx.x; i < K && i < 4000000; i += (long long)gridDim.x * 512) P.out[i * 4] += 0.002f;
    }
#endif
}

constexpr int N_PHASES = 1 + 2 * 10 + 1;

extern "C" void kernel_launch(void* const* d_in, const int* in_sizes, int n_in, void* d_out, int out_size, void* d_ws, size_t ws_size, hipStream_t stream) {
    static int grid = 0;
    if (grid == 0) {
        int dev = 0, cus = 0, per_cu = 0;
        hipGetDevice(&dev); hipDeviceGetAttribute(&cus, hipDeviceAttributeMultiprocessorCount, dev);
        hipFuncSetAttribute((const void*)fwd_kernel, hipFuncAttributeMaxDynamicSharedMemorySize, LDS_BYTES);
        hipOccupancyMaxActiveBlocksPerMultiprocessor(&per_cu, (const void*)fwd_kernel, 512, LDS_BYTES);
        if (per_cu < 1) per_cu = 1;
        grid = cus * per_cu;
        if (n_in != 22 || ws_size < WS_END) { fprintf(stderr, "kernel_launch: unexpected n_in %d / ws %zu\n", n_in, ws_size); }
    }
    Params p{};
    const float** pp = (const float**)&p;
    for (int i = 0; i < 22; ++i) pp[i] = (const float*)d_in[i];
    p.out = (float*)d_out; p.ws = (unsigned char*)d_ws;
    p.ph_lo = 0; p.ph_hi = N_PHASES;
    hipMemsetAsync(d_ws, 0, 65536, stream);
    void* args[] = {&p};
    hipError_t e = hipLaunchCooperativeKernel((const void*)fwd_kernel, dim3(grid), dim3(512), args, LDS_BYTES, stream);
    if (e != hipSuccess) fprintf(stderr, "cooperative launch failed: %s (grid %d)\n", hipGetErrorString(e), grid);
}
```

```cpp
#include <hip/hip_runtime.h>
#include <hip/hip_cooperative_groups.h>
#include <cstdio>
#include <cstdint>

namespace cg = cooperative_groups;

#define DI __device__ __forceinline__
#define LAS __attribute__((address_space(3)))
typedef unsigned short bf16_t;
typedef short bf16x8 __attribute__((ext_vector_type(8)));
typedef float f32x4 __attribute__((ext_vector_type(4)));
typedef float f32x2 __attribute__((ext_vector_type(2)));
typedef float f32x16 __attribute__((ext_vector_type(16)));
typedef unsigned u32x4 __attribute__((ext_vector_type(4)));
typedef unsigned u32x2 __attribute__((ext_vector_type(2)));
typedef __bf16 bf16x2_t __attribute__((ext_vector_type(2)));

constexpr int M = 16384, DM = 1024, SEQ = 4096, NB = 4, MEML = 256, DFF = 4096;
constexpr int NPROJ = 3072, PJW = 1280;
constexpr int IN_DIM = 2824;
constexpr float EPS = 1e-5f;

constexpr size_t MiB = 1u << 20;
constexpr size_t WS_W = 1 * MiB;
constexpr size_t WL_IN = 0, WL_OUT = 6 * MiB, WL_XQ = 8 * MiB, WL_XO = 9 * MiB, WL_FF1 = 10 * MiB, WL_FF2 = 18 * MiB, WL_SZ = 26 * MiB;
constexpr size_t WS_WMEM = WS_W + 2 * WL_SZ;
constexpr size_t WS_HB = 57 * MiB;
constexpr size_t WS_XST = WS_HB, WS_BC = WS_HB + 16 * MiB;
constexpr size_t WS_U = 89 * MiB;
constexpr size_t WS_PJ = WS_U, WS_QF = WS_U + 40 * MiB, WS_KF = WS_U + 56 * MiB, WS_VT = WS_U + 72 * MiB, WS_YALL = WS_U + 88 * MiB, WS_XQ = WS_U, WS_XAO = WS_U + 16 * MiB;
constexpr size_t WS_ST = 217 * MiB;
constexpr size_t WS_MK = 233 * MiB, WS_MVT = 235 * MiB;
constexpr size_t WS_SS = 237 * MiB;
constexpr size_t WS_DT = 238 * MiB, WS_ACUM = WS_DT + MiB / 2, WS_DTRAW = 239 * MiB;
constexpr size_t WS_MEMB = 240 * MiB;
constexpr size_t WS_RMEM = 242 * MiB;
constexpr size_t WS_END = 243 * MiB;

constexpr int LDS_BYTES = 147456;

DI unsigned pk2(float lo, float hi) { f32x2 v = {lo, hi}; bf16x2_t b = __builtin_convertvector(v, bf16x2_t); return __builtin_bit_cast(unsigned, b); }
DI float fexp(float x) { return __builtin_amdgcn_exp2f(x * 1.4426950408889634f); }
DI float flog(float x) { return __builtin_amdgcn_logf(x) * 0.6931471805599453f; }
DI float flog1p(float e) { return e < 1e-2f ? e * (1.f - e * (0.5f - e * 0.33333333f)) : flog(1.f + e); }
DI float bf2f(bf16_t v) { return __uint_as_float((unsigned)v << 16); }
DI bf16_t f2bf(float f) { return (bf16_t)(pk2(f, 0.f) & 0xffffu); }
#define GAS __attribute__((address_space(1)))
DI bf16x8 ldg8(const bf16_t* p) { return *(const GAS bf16x8*)p; }
DI void stg2(bf16_t* p, bf16_t v) { *(GAS bf16_t*)p = v; }
DI int crow(int i, int hi) { return (i & 3) + 8 * (i >> 2) + 4 * hi; }
DI int pi_inv(int key) { return 8 * ((key >> 2) & 3) + 4 * (key >> 4) + (key & 3); }
DI int pi_row(int r) { return 16 * ((r >> 2) & 1) + 4 * (r >> 3) + (r & 3); }
#define MFMA32(a, b, c) __builtin_amdgcn_mfma_f32_32x32x16_bf16((a), (b), (c), 0, 0, 0)
DI bf16x8 pack8(float a0, float a1, float a2, float a3, float a4, float a5, float a6, float a7) {
    u32x4 p; p.x = pk2(a0, a1); p.y = pk2(a2, a3); p.z = pk2(a4, a5); p.w = pk2(a6, a7); return __builtin_bit_cast(bf16x8, p);
}
DI void store_row32(bf16_t* rowp, const f32x16& o, float sc, int hi) {
#pragma unroll
    for (int m = 0; m < 2; ++m) {
        unsigned ax = pk2(o[8 * m] * sc, o[8 * m + 1] * sc), ay = pk2(o[8 * m + 2] * sc, o[8 * m + 3] * sc), bx = pk2(o[8 * m + 4] * sc, o[8 * m + 5] * sc), by = pk2(o[8 * m + 6] * sc, o[8 * m + 7] * sc);
        { auto t = __builtin_amdgcn_permlane32_swap(ax, bx, false, false); ax = t[0]; bx = t[1]; }
        { auto t = __builtin_amdgcn_permlane32_swap(ay, by, false, false); ay = t[0]; by = t[1]; }
        *(GAS u32x4*)(rowp + 16 * m + 8 * hi) = (u32x4){ax, ay, bx, by};
    }
}
DI float wave_sum(float v) {
#pragma unroll
    for (int o = 1; o < 64; o <<= 1) v += __shfl_xor(v, o);
    return v;
}
DI float row_rs(const float* SS, int row) {
    const f32x4* p = (const f32x4*)(SS + (size_t)row * 16); const f32x4 a = p[0], b = p[1], c = p[2], d = p[3];
    const float s = ((a.x + a.y) + (a.z + a.w)) + ((b.x + b.y) + (b.z + b.w)) + ((c.x + c.y) + (c.z + c.w)) + ((d.x + d.y) + (d.z + d.w));
    return __builtin_amdgcn_rsqf(s * (1.0f / 1024.0f) + EPS);
}

namespace pg8 {
#define PG8_LAS __attribute__((address_space(3)))
constexpr int BM = 256, BK = 64, HALF = 128, HTB = HALF * BK * 2, STAGE_BYTES = 8 * HTB, NXCD = 8, WGM = 8;
__host__ __device__ __forceinline__ int lds_byte(int r, int c) { const int st = (r >> 4) * 2 + (c >> 5), rr = r & 15, cc = c & 31, ob = rr * 64 + cc * 2; return st * 1024 + (ob ^ (((ob >> 9) & 1) << 5)); }
__host__ __device__ __forceinline__ void stage_rc(int b, int& R, int& C) { const int st = b / 1024, sb = b % 1024, swz = sb ^ (((sb >> 9) & 1) << 5); R = (st >> 1) * 16 + swz / 64; C = (st & 1) * 32 + (swz % 64) / 2; }
__host__ __device__ __forceinline__ int perm32(int rho) { const int n = rho >> 4, i = rho & 15; return 8 * (i >> 2) + 4 * n + (i & 3); }
struct Unit { int pm, pn; };
struct Gemm { const bf16_t* A; const bf16_t* Bt; int M, N, K; };
struct StaticOrder {
    int nM, nN, nwg, G, c;
    __host__ __device__ void init(int M_, int N_, int G_, int c_) { nM = M_ / BM; nN = N_ / BM; nwg = nM * nN; G = G_; c = c_; }
    __host__ __device__ __forceinline__ bool next(int i, Unit& u) const {
        const long L = (long)i * G + c; if (L >= nwg) return false;
        int wgid = (int)L; { const int q = nwg / NXCD, r = nwg % NXCD, xcd = wgid % NXCD, off = wgid / NXCD; wgid = (xcd < r ? xcd * (q + 1) : r * (q + 1) + (xcd - r) * q) + off; }
        const int nig = WGM * nN, gid = wgid / nig, fm = gid * WGM, gsz = (nM - fm) < WGM ? (nM - fm) : WGM;
        u.pm = fm + ((wgid % nig) % gsz); u.pn = (wgid % nig) / gsz; return true;
    }
    __device__ __forceinline__ void a_ready(const Unit&) const {}
    __device__ __forceinline__ void done(const Unit&) const {}
};

template <class Epi, class Sched, bool ALIGN_EPI = false, bool SP2 = false>
__device__ __forceinline__ void gemm_phase(PG8_LAS unsigned char* lds, const Gemm g, const Sched& S, const Epi& E, const int tid) {
    const int wid = __builtin_amdgcn_readfirstlane(tid >> 6), lane = tid & 63, wr = wid >> 2, wc = wid & 3, fr = lane & 15, fq = lane >> 4;
    const int K = g.K, nt = K / BK;
    unsigned voffA[2], voffB[2];
#pragma unroll
    for (int i = 0; i < 2; ++i) { int R, C; stage_rc(tid * 16 + i * 8192, R, C); const int Rb = Epi::PERM ? ((R & ~31) + perm32(R & 31)) : R;
        voffA[i] = (unsigned)(R * K + C) * 2u; voffB[i] = (unsigned)(Rb * K + C) * 2u; }
    const size_t kstep = (size_t)(BK * 2);
    const size_t hstep = (size_t)HALF * K * 2;
    const size_t tstep = 2 * hstep;
    const unsigned ldsw = (unsigned)wid * 1024u;
    const int aoff = lds_byte(wr * 64 + fr, fq * 8), boff = lds_byte(wc * 32 + fr, fq * 8);
#define PG8_SA(b, h) (((b) * 2 + (h)) * HTB)
#define PG8_SB(b, h) ((4 + (b) * 2 + (h)) * HTB)
#define PG8_STAGE(bufoff, gbase, voff) do { _Pragma("unroll") for (int _i = 0; _i < 2; ++_i) \
        __builtin_amdgcn_global_load_lds((const unsigned*)((const char*)(gbase) + (voff)[_i]), (PG8_LAS unsigned*)(lds + (bufoff) + ldsw + _i * 8192), 16, 0, 0); } while (0)
#define PG8_LDA(dst, b, h) do { _Pragma("unroll") for (int m = 0; m < 4; ++m) _Pragma("unroll") for (int k = 0; k < 2; ++k) dst[m][k] = *(const PG8_LAS bf16x8*)(lds + PG8_SA(b, h) + aoff + m * 2048 + k * 1024); } while (0)
#define PG8_LDB(dst, b, h) do { _Pragma("unroll") for (int n = 0; n < 2; ++n) _Pragma("unroll") for (int k = 0; k < 2; ++k) dst[n][k] = *(const PG8_LAS bf16x8*)(lds + PG8_SB(b, h) + boff + n * 2048 + k * 1024); } while (0)
#define PG8_MMA(ai, bj, At, Bt) do { __builtin_amdgcn_s_setprio(1); _Pragma("unroll") for (int m = 0; m < 4; ++m) _Pragma("unroll") for (int n = 0; n < 2; ++n) _Pragma("unroll") for (int k = 0; k < 2; ++k) \
        acc[ai][bj][m][n] = __builtin_amdgcn_mfma_f32_16x16x32_bf16(Bt[n][k], At[m][k], acc[ai][bj][m][n], 0, 0, 0); __builtin_amdgcn_s_setprio(0); } while (0)
#define PG8_WAIT_V(n) asm volatile("s_waitcnt vmcnt(" #n ")" ::: "memory")
#define PG8_WAIT_L(n) asm volatile("s_waitcnt lgkmcnt(" #n ")" ::: "memory")
#define PG8_BAR __builtin_amdgcn_s_barrier()
#define PG8_SCHED __builtin_amdgcn_sched_barrier(0)
    Unit cur, nxt; int ui = 0;
    if (!S.next(0, cur)) return;
    f32x4 acc[2][2][4][2];
#pragma unroll
    for (int a = 0; a < 2; ++a)
#pragma unroll
        for (int b = 0; b < 2; ++b)
#pragma unroll
            for (int m = 0; m < 4; ++m)
#pragma unroll
                for (int n = 0; n < 2; ++n) acc[a][b][m][n] = (f32x4){0.f, 0.f, 0.f, 0.f};
    bf16x8 At[4][2], B0[2][2], B1[2][2];
    const char* cA = (const char*)g.A + (size_t)cur.pm * tstep; const char* cB = (const char*)g.Bt + (size_t)cur.pn * tstep;
    S.a_ready(cur);
    if constexpr (SP2) {
        PG8_STAGE(PG8_SB(0, 0), cB, voffB); PG8_STAGE(PG8_SB(0, 1), cB + hstep, voffB); PG8_STAGE(PG8_SA(0, 0), cA, voffA); PG8_STAGE(PG8_SA(0, 1), cA + hstep, voffA);
        if (wr == 1) PG8_BAR;
        PG8_WAIT_V(2); PG8_BAR;
        PG8_STAGE(PG8_SB(1, 0), cB + kstep, voffB); PG8_STAGE(PG8_SA(1, 0), cA + kstep, voffA); PG8_STAGE(PG8_SB(1, 1), cB + hstep + kstep, voffB);
        PG8_WAIT_V(6); PG8_BAR;
    } else {
        PG8_STAGE(PG8_SB(0, 0), cB, voffB); PG8_STAGE(PG8_SA(0, 0), cA, voffA); PG8_STAGE(PG8_SB(0, 1), cB + hstep, voffB); PG8_STAGE(PG8_SA(0, 1), cA + hstep, voffA);
        if (wr == 1) PG8_BAR;
        PG8_WAIT_V(4); PG8_BAR;
        PG8_STAGE(PG8_SB(1, 0), cB + kstep, voffB); PG8_STAGE(PG8_SA(1, 0), cA + kstep, voffA); PG8_STAGE(PG8_SB(1, 1), cB + hstep + kstep, voffB);
        PG8_WAIT_V(6); PG8_BAR;
    }
    for (;;) {
        const bool has_next = S.next(ui + 1, nxt);
        const char* nA = has_next ? (const char*)g.A + (size_t)nxt.pm * tstep : cA; const char* nB = has_next ? (const char*)g.Bt + (size_t)nxt.pn * tstep : cB;
        for (int t = 0; t < nt; t += 2) {
            const bool last = (t == nt - 2);
            const char* a1 = cA + (size_t)(t + 1) * kstep;
            const char* a2 = last ? nA : cA + (size_t)(t + 2) * kstep; const char* b2 = last ? nB : cB + (size_t)(t + 2) * kstep;
            const char* a3 = a2 + kstep; const char* b3 = b2 + kstep;
            if (last && has_next) S.a_ready(nxt);
            if constexpr (SP2) {
            PG8_LDB(B0, 0, 0); PG8_LDB(B1, 0, 1); PG8_SCHED; PG8_LDA(At, 0, 0); PG8_STAGE(PG8_SA(1, 1), a1 + hstep, voffA);
            PG8_WAIT_V(8); PG8_WAIT_L(0); PG8_BAR; PG8_MMA(0, 0, At, B0); PG8_MMA(0, 1, At, B1); PG8_BAR; PG8_SCHED;
            PG8_LDA(At, 0, 1); PG8_STAGE(PG8_SB(0, 0), b2, voffB); PG8_STAGE(PG8_SB(0, 1), b2 + hstep, voffB); PG8_STAGE(PG8_SA(0, 0), a2, voffA);
            PG8_WAIT_V(8); PG8_WAIT_L(0); PG8_BAR; PG8_MMA(1, 0, At, B0); PG8_MMA(1, 1, At, B1); PG8_BAR; PG8_SCHED;
            PG8_LDB(B0, 1, 0); PG8_LDB(B1, 1, 1); PG8_SCHED; PG8_LDA(At, 1, 0); PG8_STAGE(PG8_SA(0, 1), a2 + hstep, voffA);
            PG8_WAIT_V(8); PG8_WAIT_L(0); PG8_BAR; PG8_MMA(0, 0, At, B0); PG8_MMA(0, 1, At, B1); PG8_BAR; PG8_SCHED;
            PG8_LDA(At, 1, 1); PG8_STAGE(PG8_SB(1, 0), b3, voffB); PG8_STAGE(PG8_SB(1, 1), b3 + hstep, voffB); PG8_STAGE(PG8_SA(1, 0), a3, voffA);
            PG8_WAIT_V(8); PG8_WAIT_L(0); PG8_BAR; PG8_MMA(1, 0, At, B0); PG8_MMA(1, 1, At, B1); PG8_BAR; PG8_SCHED;
            } else {
            PG8_LDB(B0, 0, 0); PG8_SCHED; PG8_LDA(At, 0, 0); PG8_STAGE(PG8_SA(1, 1), a1 + hstep, voffA);
            PG8_WAIT_L(8); PG8_BAR; PG8_WAIT_L(0); PG8_MMA(0, 0, At, B0); PG8_BAR; PG8_SCHED;
            PG8_LDB(B1, 0, 1); PG8_STAGE(PG8_SB(0, 0), b2, voffB);
            PG8_BAR; PG8_WAIT_L(0); PG8_MMA(0, 1, At, B1); PG8_BAR;
            PG8_LDA(At, 0, 1); PG8_STAGE(PG8_SA(0, 0), a2, voffA);
            PG8_BAR; PG8_WAIT_L(0); PG8_MMA(1, 0, At, B0); PG8_BAR; PG8_SCHED;
            PG8_STAGE(PG8_SB(0, 1), b2 + hstep, voffB);
            PG8_WAIT_V(6); PG8_BAR; PG8_MMA(1, 1, At, B1); PG8_BAR;
            PG8_LDB(B0, 1, 0); PG8_SCHED; PG8_LDA(At, 1, 0); PG8_STAGE(PG8_SA(0, 1), a2 + hstep, voffA);
            PG8_WAIT_L(8); PG8_BAR; PG8_WAIT_L(0); PG8_MMA(0, 0, At, B0); PG8_BAR; PG8_SCHED;
            PG8_LDB(B1, 1, 1); PG8_STAGE(PG8_SB(1, 0), b3, voffB);
            PG8_BAR; PG8_WAIT_L(0); PG8_MMA(0, 1, At, B1); PG8_BAR;
            PG8_LDA(At, 1, 1); PG8_STAGE(PG8_SA(1, 0), a3, voffA);
            PG8_BAR; PG8_WAIT_L(0); PG8_MMA(1, 0, At, B0); PG8_BAR; PG8_SCHED;
            PG8_STAGE(PG8_SB(1, 1), b3 + hstep, voffB);
            PG8_WAIT_V(6); PG8_BAR; PG8_MMA(1, 1, At, B1); PG8_BAR;
            }
        }
        if constexpr (ALIGN_EPI) { if (wr == 0) PG8_BAR; }
        if constexpr (!Epi::AFTER_DRAIN) { E(acc, cur, wr, wc, fr, fq, ui); } S.done(cur);
        if (!has_next) break;
#pragma unroll
        for (int a = 0; a < 2; ++a)
#pragma unroll
            for (int b = 0; b < 2; ++b)
#pragma unroll
                for (int m = 0; m < 4; ++m)
#pragma unroll
                    for (int n = 0; n < 2; ++n) acc[a][b][m][n] = (f32x4){0.f, 0.f, 0.f, 0.f};
        cur = nxt; cA = nA; cB = nB; ++ui;
        if constexpr (ALIGN_EPI) { if (wr == 1) PG8_BAR; }
    }
    PG8_WAIT_V(0);
    if constexpr (!ALIGN_EPI) { if (wr == 0) PG8_BAR; }
    PG8_BAR;
    if constexpr (Epi::AFTER_DRAIN) E.fused(acc, cur, wr, wc, fr, fq, lds, wid, lane);
#undef PG8_SA
#undef PG8_SB
#undef PG8_STAGE
#undef PG8_LDA
#undef PG8_LDB
#undef PG8_MMA
#undef PG8_WAIT_V
#undef PG8_WAIT_L
#undef PG8_BAR
#undef PG8_SCHED
}
}
using pg8::Unit;

DI void stwt16(void* p, u32x4 w) { asm volatile("global_store_dwordx4 %0, %1, off sc1\n\ts_nop 1" :: "v"(p), "v"(w) : "memory"); }
DI void st8(bf16_t* p, f32x4 v0, f32x4 v1) { u32x4 w; w.x = pk2(v0[0], v0[1]); w.y = pk2(v0[2], v0[3]); w.z = pk2(v1[0], v1[1]); w.w = pk2(v1[2], v1[3]); stwt16(p, w); }

DI u32x4 tr8x8(u32x4 p, int i) {
    {   const bool up = (i & 4) != 0; const unsigned s0 = up ? p.x : p.z, s1 = up ? p.y : p.w;
        const unsigned r0 = __shfl_xor(s0, 4), r1 = __shfl_xor(s1, 4);
        p.x = up ? r0 : p.x; p.y = up ? r1 : p.y; p.z = up ? p.z : r0; p.w = up ? p.w : r1; }
    {   const bool up = (i & 2) != 0; const unsigned s0 = up ? p.x : p.y, s1 = up ? p.z : p.w;
        const unsigned r0 = __shfl_xor(s0, 2), r1 = __shfl_xor(s1, 2);
        p.x = up ? r0 : p.x; p.z = up ? r1 : p.z; p.y = up ? p.y : r0; p.w = up ? p.w : r1; }
    {   const bool up = (i & 1) != 0;
#pragma unroll
        for (int k = 0; k < 4; ++k) { const unsigned q = __shfl_xor(p[k], 1); const unsigned a = (q >> 16) | (p[k] & 0xffff0000u), c = (p[k] & 0xffffu) | (q << 16); p[k] = up ? a : c; } }
    return p;
}
struct EpiProj {
    static constexpr bool PERM = true, AFTER_DRAIN = false;
    bf16_t* PJ; bf16_t* QF; bf16_t* KF; bf16_t* VT; float* DTRAW; const LAS float* rsl;
    DI void operator()(const f32x4 (&acc)[2][2][4][2], const Unit& u, int wr, int wc, int fr, int fq, int ui) const {
        const int row0 = u.pm * 256 + wr * 64 + fr;
#pragma unroll
        for (int ai = 0; ai < 2; ++ai)
#pragma unroll
            for (int m = 0; m < 4; ++m) {
                const int row = row0 + ai * 128 + m * 16; const float rs = rsl[ui * 256 + (row & 255)];
#pragma unroll
                for (int bj = 0; bj < 2; ++bj) {
                    const f32x4 v0 = acc[ai][bj][m][0] * rs, v1 = acc[ai][bj][m][1] * rs; const int col = u.pn * 256 + bj * 128 + wc * 32 + 8 * fq;
                    const int b = row >> 12, t = row & 4095;
                    if (u.pn < 5) st8(PJ + (size_t)row * PJW + col, v0, v1);
                    else if (u.pn < 9) {
                        const bool isk = u.pn >= 7; const int cp = col - (isk ? 1792 : 1280), head = cp >> 6, d = cp & 63;
                        const int ln = ((d >> 3) & 1) * 32 + (isk ? pi_inv(t & 31) : (t & 31));
                        st8((isk ? KF : QF) + ((size_t)(((b * 8 + head) * 128 + (t >> 5)) * 4 + (d >> 4))) * 512 + ln * 8, v0, v1); }
                    else if (u.pn < 11) {
                        const int cp = col - 2304, head = cp >> 6, i8 = fr & 7, d = (cp & 63) + i8, t0 = t & ~7;
                        u32x4 w; w.x = pk2(v0[0], v0[1]); w.y = pk2(v0[2], v0[3]); w.z = pk2(v1[0], v1[1]); w.w = pk2(v1[2], v1[3]);
                        w = tr8x8(w, i8);
                        stwt16(VT + ((size_t)((((b * 8 + head) * 128 + (t0 >> 5)) * 2 + (d >> 5)) * 2 + ((t0 >> 3) & 1))) * 512 + (((t0 >> 4) & 1) * 32 + (d & 31)) * 8, w); }
                    else if (bj == 0 && wc == 0 && fq == 0) { *(f32x4*)(DTRAW + (size_t)row * 8) = v0; *(f32x4*)(DTRAW + (size_t)row * 8 + 4) = v1; }
                }
            }
    }
};
struct EpiResid {
    static constexpr bool PERM = true, AFTER_DRAIN = false;
    bf16_t* HB; float* SS;
    DI void operator()(const f32x4 (&acc)[2][2][4][2], const Unit& u, int wr, int wc, int fr, int fq, int ui) const {
        const int row0 = u.pm * 256 + wr * 64 + fr, col0 = u.pn * 256 + wc * 32 + 8 * fq;
#pragma unroll
        for (int ai = 0; ai < 2; ++ai) {
            u32x4 hbv[4][2];
#pragma unroll
            for (int m = 0; m < 4; ++m)
#pragma unroll
                for (int bj = 0; bj < 2; ++bj) hbv[m][bj] = *(const GAS u32x4*)(HB + (size_t)(row0 + ai * 128 + m * 16) * DM + col0 + bj * 128);
#pragma unroll
            for (int m = 0; m < 4; ++m) {
                const int row = row0 + ai * 128 + m * 16; bf16_t* hp = HB + (size_t)row * DM + col0; float s = 0.f;
#pragma unroll
                for (int bj = 0; bj < 2; ++bj) {
                    const u32x4 hb = hbv[m][bj]; u32x4 w;
#pragma unroll
                    for (int e = 0; e < 4; ++e) {
                        const float a0 = (e < 2 ? acc[ai][bj][m][0][2 * e] : acc[ai][bj][m][1][2 * e - 4]), a1 = (e < 2 ? acc[ai][bj][m][0][2 * e + 1] : acc[ai][bj][m][1][2 * e - 3]);
                        const float v0 = __uint_as_float(hb[e] << 16) + a0, v1 = __uint_as_float(hb[e] & 0xffff0000u) + a1;
                        const unsigned pk = pk2(v0, v1); w[e] = pk;
                        const float r0 = __uint_as_float(pk << 16), r1 = __uint_as_float(pk & 0xffff0000u); s += r0 * r0 + r1 * r1;
                    }
                    stwt16(hp + bj * 128, w);
                }
                s += __shfl_xor(s, 16); s += __shfl_xor(s, 32);
                if (fq == 0) *(GAS float*)(SS + (size_t)row * 16 + u.pn * 4 + wc) = s;
            }
        }
    }
};
struct EpiFinal {
    static constexpr bool PERM = true, AFTER_DRAIN = true;
    const bf16_t* HB; float* out; const float* fg; float* xch; unsigned* cnt;
    DI void operator()(const f32x4 (&)[2][2][4][2], const Unit&, int, int, int, int, int) const {}
    DI void fused(f32x4 (&acc)[2][2][4][2], const Unit& u, int wr, int wc, int fr, int fq, LAS unsigned char* lds, int wid, int lane) const {
        LAS float* Pt = (LAS float*)lds;
        LAS float* St = (LAS float*)(lds + 4096);
        const int row0 = u.pm * 256 + wr * 64 + fr, col0 = u.pn * 256 + wc * 32 + 8 * fq;
#pragma unroll
        for (int ai = 0; ai < 2; ++ai) {
            u32x4 hbv[4][2];
#pragma unroll
            for (int m = 0; m < 4; ++m)
#pragma unroll
                for (int bj = 0; bj < 2; ++bj) hbv[m][bj] = *(const GAS u32x4*)(HB + (size_t)(row0 + ai * 128 + m * 16) * DM + col0 + bj * 128);
#pragma unroll
            for (int m = 0; m < 4; ++m) { float s = 0.f;
#pragma unroll
                for (int bj = 0; bj < 2; ++bj) { const u32x4 hb = hbv[m][bj];
#pragma unroll
                    for (int e = 0; e < 4; ++e) { const int n = e >> 1, j = (e & 1) * 2;
                        const float v0 = __uint_as_float(hb[e] << 16) + acc[ai][bj][m][n][j], v1 = __uint_as_float(hb[e] & 0xffff0000u) + acc[ai][bj][m][n][j + 1];
                        acc[ai][bj][m][n][j] = v0; acc[ai][bj][m][n][j + 1] = v1; s += v0 * v0 + v1 * v1; } }
                s += __shfl_xor(s, 16); s += __shfl_xor(s, 32);
                if (fq == 0) Pt[(wr * 64 + ai * 128 + m * 16 + fr) * 4 + wc] = s; }
        }
        __syncthreads();
        int t = threadIdx.x; asm volatile("" : "+v"(t));
        if (t < 256) { const f32x4 p = *(const LAS f32x4*)(Pt + t * 4);
            __hip_atomic_store(xch + (size_t)(u.pm * 256 + t) * 4 + u.pn, (p.x + p.y) + (p.z + p.w), __ATOMIC_RELAXED, __HIP_MEMORY_SCOPE_AGENT); }
        asm volatile("s_waitcnt vmcnt(0)" ::: "memory");
        if (t < 256 && lane == 0) __hip_atomic_fetch_add(cnt + 64 * u.pm, 1u, __ATOMIC_RELAXED, __HIP_MEMORY_SCOPE_AGENT);
        if (wid == 0) { unsigned sp = 0;
            while ((unsigned)__builtin_amdgcn_readfirstlane(__hip_atomic_load(cnt + 64 * u.pm, __ATOMIC_RELAXED, __HIP_MEMORY_SCOPE_AGENT)) < 16u) { __builtin_amdgcn_s_sleep(1); if (++sp > (1u << 22)) break; }
            __builtin_amdgcn_fence(__ATOMIC_ACQUIRE, "agent"); }
        asm volatile("s_waitcnt vmcnt(0) lgkmcnt(0)" ::: "memory");
        __syncthreads();
        if (t < 256) { const float* sl = xch + (size_t)(u.pm * 256 + t) * 4; float q = 0.f;
#pragma unroll
            for (int k = 0; k < 4; ++k) q += __hip_atomic_load(sl + k, __ATOMIC_RELAXED, __HIP_MEMORY_SCOPE_AGENT);
            St[t] = __builtin_amdgcn_rsqf(q * (1.0f / 1024.0f) + EPS); }
        __syncthreads();
        f32x4 g[2][2];
#pragma unroll
        for (int bj = 0; bj < 2; ++bj) { g[bj][0] = *(const GAS f32x4*)(fg + col0 + bj * 128); g[bj][1] = *(const GAS f32x4*)(fg + col0 + bj * 128 + 4); }
#pragma unroll
        for (int ai = 0; ai < 2; ++ai)
#pragma unroll
            for (int m = 0; m < 4; ++m) { const int lr = wr * 64 + ai * 128 + m * 16 + fr; const float rs = St[lr]; float* op = out + (size_t)(u.pm * 256 + lr) * DM + col0;
#pragma unroll
                for (int bj = 0; bj < 2; ++bj) { *(GAS f32x4*)(op + bj * 128) = acc[ai][bj][m][0] * rs * g[bj][0]; *(GAS f32x4*)(op + bj * 128 + 4) = acc[ai][bj][m][1] * rs * g[bj][1]; } }
    }
};
template <int ACT> struct EpiScale {
    static constexpr bool PERM = true, AFTER_DRAIN = false;
    bf16_t* O; int ldc; const LAS float* rsl;
    DI void operator()(const f32x4 (&acc)[2][2][4][2], const Unit& u, int wr, int wc, int fr, int fq, int ui) const {
        const int row0 = u.pm * 256 + wr * 64 + fr;
#pragma unroll
        for (int ai = 0; ai < 2; ++ai)
#pragma unroll
            for (int m = 0; m < 4; ++m) {
                const int row = row0 + ai * 128 + m * 16; const float rs = rsl[ui * 256 + (row & 255)];
#pragma unroll
                for (int bj = 0; bj < 2; ++bj) {
                    f32x4 v0 = acc[ai][bj][m][0] * rs, v1 = acc[ai][bj][m][1] * rs;
                    if (ACT == 1) {
#pragma unroll
                        for (int e = 0; e < 4; ++e) { const float a = __builtin_fmaxf(v0[e], 0.f), b = __builtin_fmaxf(v1[e], 0.f); v0[e] = a * a; v1[e] = b * b; }
                    }
                    { u32x4 w; w.x = pk2(v0[0], v0[1]); w.y = pk2(v0[2], v0[3]); w.z = pk2(v1[0], v1[1]); w.w = pk2(v1[2], v1[3]);
                        const int col = u.pn * 256 + bj * 128 + wc * 32 + 8 * fq;
                        if (ACT == 0) {
                            const int hd = col >> 7, d = col & 127;
                            *(GAS u32x4*)(O + ((size_t)(((row >> 5) * 4 + hd) * 8 + (d >> 4))) * 512 + (((d >> 3) & 1) * 32 + (row & 31)) * 8) = w;
                        } else *(GAS u32x4*)(O + (size_t)row * ldc + col) = w; }
                }
            }
    }
};
struct EpiMem {
    static constexpr bool PERM = true, AFTER_DRAIN = false;
    bf16_t* MK; bf16_t* MVT; const float* RMEM;
    DI void operator()(const f32x4 (&acc)[2][2][4][2], const Unit& u, int wr, int wc, int fr, int fq, int ui) const {
        const int row0 = u.pm * 256 + wr * 64 + fr;
#pragma unroll
        for (int ai = 0; ai < 2; ++ai)
#pragma unroll
            for (int m = 0; m < 4; ++m) {
                const int row = row0 + ai * 128 + m * 16; const float rs = RMEM[row]; const int b = row >> 8, mm = row & 255;
#pragma unroll
                for (int bj = 0; bj < 2; ++bj) {
                    const f32x4 v0 = acc[ai][bj][m][0] * rs, v1 = acc[ai][bj][m][1] * rs; const int c = u.pn * 256 + bj * 128 + wc * 32 + 8 * fq;
                    const int layer = c >> 10, kv = (c >> 9) & 1, head = (c >> 7) & 3, d = c & 127;
                    const size_t hb = (size_t)((layer * 4 + b) * 4 + head) * 32768;
                    if (kv == 0) st8(MK + hb + ((size_t)((mm >> 5) * 8 + (d >> 4))) * 512 + (((d >> 3) & 1) * 32 + pi_inv(mm & 31)) * 8, v0, v1);
                    else { bf16_t* p = MVT + hb + ((size_t)(((mm >> 5) * 4 + (d >> 5)) * 2 + ((mm >> 3) & 1))) * 512 + (((mm >> 4) & 1) * 32 + (d & 31)) * 8 + (mm & 7);
                        stg2(p, f2bf(v0[0])); stg2(p + 8, f2bf(v0[1])); stg2(p + 16, f2bf(v0[2])); stg2(p + 24, f2bf(v0[3]));
                        stg2(p + 32, f2bf(v1[0])); stg2(p + 40, f2bf(v1[1])); stg2(p + 48, f2bf(v1[2])); stg2(p + 56, f2bf(v1[3])); }
                }
            }
    }
};


#define RLX_AGENT __ATOMIC_RELAXED, __HIP_MEMORY_SCOPE_AGENT
#define XB_TMO      128
#define XB_XCNT(j)  (256  + 64 * (j))
#define XB_XSUB(j)  (1280 + 64 * (j))
#define XB_XGEN(j)  (2304 + 64 * (j))
#define XB_TOP      3328
#define XB_TOPGEN   3392
#define XCD_BAR_WORDS 3456
#define XB_SPIN_CAP (1u << 18)
DI unsigned xb_ld(unsigned* p)              { return __hip_atomic_load(p, __ATOMIC_RELAXED, __HIP_MEMORY_SCOPE_AGENT); }
DI unsigned xb_add(unsigned* p, unsigned v) { return __hip_atomic_fetch_add(p, v, __ATOMIC_RELAXED, __HIP_MEMORY_SCOPE_AGENT); }
DI unsigned xb_xcc_id() { return (unsigned)__builtin_amdgcn_s_getreg((3 << 11) | 20) & 0xFu; }
#define XB_SPIN(cond, bar) do { unsigned _sp = 0; while (cond) { __builtin_amdgcn_s_sleep(1); \
    if ((++_sp & 255u) == 0u) { if (xb_ld(&(bar)[XB_TMO])) break; if (_sp > XB_SPIN_CAP) { atomicAdd(&(bar)[XB_TMO], 1u); break; } } } } while (0)
struct XcdBarrier { unsigned* bar; unsigned x; volatile LAS unsigned* st; };
DI XcdBarrier xcd_barrier_post(unsigned* bar, volatile LAS unsigned* st) {
    XcdBarrier b; b.bar = bar; b.x = xb_xcc_id(); b.st = st;
    if (threadIdx.x == 0) (void)xb_add(&bar[XB_XCNT(b.x)], 1u);
    return b;
}
DI void xcd_barrier_complete(unsigned* bar, unsigned x, unsigned& nloc, unsigned& nx) {
    const unsigned G = gridDim.x * gridDim.y * gridDim.z;
    unsigned sum, cnt, mine, sp = 0u;
    for (;;) {
        sum = 0u; cnt = 0u; mine = 0u;
#pragma unroll
        for (unsigned j = 0; j < 16; ++j) { const unsigned c = xb_ld(&bar[XB_XCNT(j)]); sum += c; cnt += (c > 0u) ? 1u : 0u; mine = (j == x) ? c : mine; }
        if (sum == G) break;
        __builtin_amdgcn_s_sleep(1);
        if ((++sp & 255u) == 0u) { if (xb_ld(&bar[XB_TMO])) break; if (sp > XB_SPIN_CAP) { atomicAdd(&bar[XB_TMO], 1u); break; } }
    }
    nloc = mine > 0u ? mine : 1u; nx = cnt > 0u ? cnt : 1u;
}
DI void xcd_barrier(const XcdBarrier& b) {
    asm volatile("s_waitcnt vmcnt(0)" ::: "memory");
    __syncthreads();
    if (threadIdx.x == 0) {
        unsigned* bar = b.bar;
        __builtin_amdgcn_s_waitcnt(0);
        unsigned nloc = b.st[0], nx = b.st[1];
        if (nloc == 0u) { xcd_barrier_complete(bar, b.x, nloc, nx); b.st[0] = nloc; b.st[1] = nx; }
        const unsigned old = xb_add(&bar[XB_XSUB(b.x)], 1u);
        const unsigned gen = old / nloc;
        if (old + 1u == (gen + 1u) * nloc) {
            __builtin_amdgcn_fence(__ATOMIC_RELEASE, "agent");
            asm volatile("s_waitcnt vmcnt(0)" ::: "memory");
            const unsigned og = xb_add(&bar[XB_TOP], 1u);
            const unsigned tg = og / nx;
            if (og + 1u == (tg + 1u) * nx) xb_add(&bar[XB_TOPGEN], 1u);
            else XB_SPIN(xb_ld(&bar[XB_TOPGEN]) == tg, bar);
            __builtin_amdgcn_fence(__ATOMIC_ACQUIRE, "agent");
            xb_add(&bar[XB_XGEN(b.x)], 1u);
            asm volatile("s_waitcnt vmcnt(0)" ::: "memory");
        } else {
            XB_SPIN(xb_ld(&bar[XB_XGEN(b.x)]) == gen, bar);
            __builtin_amdgcn_fence(__ATOMIC_ACQUIRE, "agent");
            asm volatile("s_waitcnt vmcnt(0)" ::: "memory");
        }
    }
    __syncthreads();
}

DI void sb_block(unsigned char* ws, const bf16_t* VT, int b, int h, int qb, int lane, int r, int hi, f32x16& o0, f32x16& o1) {
    bf16x8 qf[4];
#pragma unroll
    for (int s = 0; s < 4; ++s) qf[s] = ldg8((const bf16_t*)(ws + WS_QF) + ((size_t)(((b * 8 + h) * 128 + qb) * 4 + s)) * 512 + lane * 8);
    float R = 0.f;
    const bf16_t* Kb = (const bf16_t*)(ws + WS_KF) + ((size_t)((b * 8 + h) * 128)) * 2048 + lane * 8;
    const bf16_t* Vb = VT + ((size_t)((b * 8 + h) * 128)) * 2048 + lane * 8;
    bf16x8 kf[4];
#pragma unroll
    for (int s4 = 0; s4 < 4; ++s4) kf[s4] = ldg8(Kb + (size_t)qb * 2048 + s4 * 512);
    for (int kt = qb; kt >= 0; --kt) {
        bf16x8 vf[2][2];
#pragma unroll
        for (int d = 0; d < 2; ++d)
#pragma unroll
            for (int j = 0; j < 2; ++j) vf[d][j] = ldg8(Vb + (size_t)kt * 2048 + (d * 2 + j) * 512);
        f32x16 st = {};
#pragma unroll
        for (int s4 = 0; s4 < 4; ++s4) st = MFMA32(kf[s4], qf[s4], st);
        {   const int kn = kt > 0 ? kt - 1 : 0;
#pragma unroll
            for (int s4 = 0; s4 < 4; ++s4) kf[s4] = ldg8(Kb + (size_t)kn * 2048 + s4 * 512); }
        float w[16]; float suf = 0.f;
        if (kt == qb) {
#pragma unroll
            for (int i = 0; i < 16; ++i) if (16 * hi + i >= r) st[i] = -INFINITY;
        }
#pragma unroll
        for (int i = 15; i >= 0; --i) {
            const float z = st[i] * 0.125f; const float sp = __builtin_fmaxf(z, 0.f) + flog(1.f + fexp(-__builtin_fabsf(z)));
            w[i] = (z - sp) + suf; suf -= sp;
        }
        const float other = __shfl_xor(suf, 32);
        const float add = R + (hi == 0 ? other : 0.f);
#pragma unroll
        for (int i = 0; i < 16; ++i) w[i] = fexp(w[i] + add);
        R += suf + other;
        const bf16x8 pa0 = pack8(w[0], w[1], w[2], w[3], w[4], w[5], w[6], w[7]), pa1 = pack8(w[8], w[9], w[10], w[11], w[12], w[13], w[14], w[15]);
        o0 = MFMA32(vf[0][0], pa0, o0); o0 = MFMA32(vf[0][1], pa1, o0); o1 = MFMA32(vf[1][0], pa0, o1); o1 = MFMA32(vf[1][1], pa1, o1);
        if (__all(R < -88.f)) break;
    }
}

struct Params {
    const float* x; const float* mem; const float* norm_mix_g; const float* w_in; const float* conv_w; const float* conv_b; const float* dt_bias; const float* a_log;
    const float* d_skip; const float* ssd_norm_g; const float* sb_norm_g; const float* w_out; const float* norm_xa_g; const float* norm_mem_g;
    const float* w_xq; const float* w_xk; const float* w_xv; const float* w_xo; const float* norm_ff_g; const float* w_ff1; const float* w_ff2; const float* final_g;
    float* out; unsigned char* ws; int ph_lo, ph_hi;
};

#define LDS_WAIT() asm volatile("s_waitcnt lgkmcnt(0)" ::: "memory")

struct TDesc { const float* W; bf16_t* WT; const float* g1; const float* g2; int K, N, gsplit, mode, item; };
DI void tr_load(const TDesc& d, int lane, f32x4 (&v)[16], float (&gv)[16]) {
    const int nblk = (d.N + 63) / 64, kb = d.item / nblk, nb = d.item % nblk, k0 = 64 * kb, n0 = 64 * nb;
    const int n4 = lane & 15, sub = lane >> 4, n = n0 + 4 * n4; const bool ok = n < d.N;
#pragma unroll
    for (int i = 0; i < 16; ++i) v[i] = ok ? __builtin_nontemporal_load((const GAS f32x4*)(d.W + (size_t)(k0 + 4 * i + sub) * d.N + n)) : (f32x4){0.f, 0.f, 0.f, 0.f};
#pragma unroll
    for (int i = 0; i < 16; ++i) { const int kg = k0 + 4 * i + sub; gv[i] = d.mode == 2 ? 1.f : (kg < d.gsplit ? d.g1[kg] : d.g2[kg - d.gsplit]); }
}
DI void tr_finish(const TDesc& d, int lane, const f32x4 (&v)[16], const float (&gv)[16], LAS float* scr) {
    const int nblk = (d.N + 63) / 64, kb = d.item / nblk, nb = d.item % nblk, k0 = 64 * kb, n0 = 64 * nb;
    const int n4 = lane & 15, sub = lane >> 4;
#pragma unroll
    for (int i = 0; i < 16; ++i) { const int kl = 4 * i + sub; LAS float* p = scr + (4 * n4) * 65 + kl; p[0] = v[i].x * gv[i]; p[65] = v[i].y * gv[i]; p[130] = v[i].z * gv[i]; p[195] = v[i].w * gv[i]; }
    LDS_WAIT();
    const int c = lane & 7;
#pragma unroll
    for (int j = 0; j < 8; ++j) { const int nl = (lane >> 3) + 8 * j, nn = n0 + nl;
        if (nn < d.N) { int dr = nn; if (d.mode == 1) dr = (nn < 1280) ? nn : (nn < 1288 ? 2816 + (nn - 1280) : nn - 8);
            const LAS float* sp = scr + nl * 65 + 8 * c;
            u32x4 o; o.x = pk2(sp[0], sp[1]); o.y = pk2(sp[2], sp[3]); o.z = pk2(sp[4], sp[5]); o.w = pk2(sp[6], sp[7]);
            *(GAS u32x4*)(d.WT + (size_t)dr * d.K + k0 + 8 * c) = o; } }
    LDS_WAIT();
}
DI float row_to_bf16(const float* xrow, bf16_t* orow, int lane) {
    const f32x4* xr = (const f32x4*)xrow + lane; f32x4 v[4]; float s = 0.f;
#pragma unroll
    for (int j = 0; j < 4; ++j) { v[j] = xr[64 * j]; s += (v[j].x * v[j].x + v[j].y * v[j].y) + (v[j].z * v[j].z + v[j].w * v[j].w); }
    u32x2* o8 = (u32x2*)orow + lane;
#pragma unroll
    for (int j = 0; j < 4; ++j) { u32x2 w; w.x = pk2(v[j].x, v[j].y); w.y = pk2(v[j].z, v[j].w); o8[64 * j] = w; }
    return wave_sum(s);
}

constexpr int I_IN = 16 * 45, I_OUT = 16 * 16, I_XQ = 16 * 8, I_XO = 8 * 16, I_F1 = 16 * 64, I_F2 = 64 * 16;
constexpr int Q_OUT = I_IN, Q_XQ = Q_OUT + I_OUT, Q_XK = Q_XQ + I_XQ, Q_XO = Q_XK + 2 * I_XQ, Q_F1 = Q_XO + I_XO, Q_F2 = Q_F1 + I_F1, I_L = Q_F2 + I_F2;
DI TDesc get_desc(const Params& P, unsigned char* ws, int l, int q) {
    unsigned char* wl = ws + WS_W + (size_t)l * WL_SZ; bf16_t* WMEM = (bf16_t*)(ws + WS_WMEM);
    TDesc d; d.K = DM; d.g1 = P.final_g; d.g2 = P.final_g; d.gsplit = 1 << 30; d.mode = 0;
    if (q < I_IN) { d.W = P.w_in + (size_t)l * DM * IN_DIM; d.N = IN_DIM; d.WT = (bf16_t*)(wl + WL_IN); d.g1 = P.norm_mix_g + l * DM; d.mode = 1; }
    else if ((q -= I_IN) < I_OUT) { d.W = P.w_out + (size_t)l * DM * DM; d.N = DM; d.WT = (bf16_t*)(wl + WL_OUT); d.g1 = P.ssd_norm_g + l * 512; d.g2 = P.sb_norm_g + l * 512; d.gsplit = 512; }
    else if ((q -= I_OUT) < I_XQ) { d.W = P.w_xq + (size_t)l * DM * 512; d.N = 512; d.WT = (bf16_t*)(wl + WL_XQ); d.g1 = P.norm_xa_g + l * DM; }
    else if ((q -= I_XQ) < I_XQ) { d.W = P.w_xk + (size_t)l * DM * 512; d.N = 512; d.WT = WMEM + (size_t)(l * 1024) * DM; d.g1 = P.norm_mem_g + l * DM; }
    else if ((q -= I_XQ) < I_XQ) { d.W = P.w_xv + (size_t)l * DM * 512; d.N = 512; d.WT = WMEM + (size_t)(l * 1024 + 512) * DM; d.g1 = P.norm_mem_g + l * DM; }
    else if ((q -= I_XQ) < I_XO) { d.W = P.w_xo + (size_t)l * 512 * DM; d.K = 512; d.N = DM; d.WT = (bf16_t*)(wl + WL_XO); d.mode = 2; }
    else if ((q -= I_XO) < I_F1) { d.W = P.w_ff1 + (size_t)l * DM * DFF; d.N = DFF; d.WT = (bf16_t*)(wl + WL_FF1); d.g1 = P.norm_ff_g + l * DM; }
    else { q -= I_F1; d.W = P.w_ff2 + (size_t)l * DFF * DM; d.K = DFF; d.N = DM; d.WT = (bf16_t*)(wl + WL_FF2); d.mode = 2; }
    d.item = q; return d;
}
DI void convert_items(const Params& P, unsigned char* ws, int l, int q_lo, int q_hi, int gw, int NGW, LAS float* scr, int lane) {
    int it = q_lo + gw; if (it >= q_hi) return;
    TDesc dc = get_desc(P, ws, l, it); f32x4 vc[16]; float gc[16]; tr_load(dc, lane, vc, gc);
    for (;;) {
        const int nx = it + NGW; const bool has = nx < q_hi;
        TDesc dn = dc; f32x4 vn[16]; float gn[16];
#pragma unroll
        for (int i = 0; i < 16; ++i) { vn[i] = vc[i]; gn[i] = gc[i]; }
        if (has) { dn = get_desc(P, ws, l, nx); tr_load(dn, lane, vn, gn); }
        tr_finish(dc, lane, vc, gc, scr);
        if (!has) break;
        dc = dn; it = nx;
#pragma unroll
        for (int i = 0; i < 16; ++i) { vc[i] = vn[i]; gc[i] = gn[i]; }
    }
}

__global__ void __launch_bounds__(512, 2) fwd_kernel(Params P) {
    extern __shared__ __attribute__((aligned(16))) unsigned char lds_raw[];
    LAS unsigned char* lds = (LAS unsigned char*)lds_raw;
    cg::grid_group grid = cg::this_grid();
    if (P.ph_hi == 12345) grid.sync();
    volatile LAS unsigned* xst = (volatile LAS unsigned*)(lds + 147200);
    if (threadIdx.x < 64) xst[threadIdx.x] = 0u;
    __syncthreads();
    const XcdBarrier xbar = xcd_barrier_post((unsigned*)P.ws + 4096, xst);
    const int lo = P.ph_lo, hi_ph = P.ph_hi - ((gridDim.x == 256) ? 1 : 0);
    int ph = 0;
    int layer = 0;
#ifdef TS_LO
#define TS_STAMP() do { if (blockIdx.x == 0 && threadIdx.x == 0) ((unsigned long long*)P.ws)[ph] = __builtin_amdgcn_s_memrealtime(); } while (0)
#else
#define TS_STAMP() do {} while (0)
#endif
#ifndef RP
#define RP -1
#endif
#define PHASE_BEGIN TS_STAMP(); if (ph >= lo && ph < hi_ph) { for (int rep_ = 0; rep_ < ((ph == RP) ? 2 : 1); ++rep_) { \
    int tid = threadIdx.x; asm volatile("" : "+v"(tid)); int bx = blockIdx.x; asm volatile("" : "+s"(bx)); unsigned char* ws = P.ws; asm volatile("" : "+s"(ws)); \
    const int lane = tid & 63, wave = __builtin_amdgcn_readfirstlane(tid >> 6), G = gridDim.x, vcu = (G % 8 == 0) ? (bx % 8) * (G / 8) + bx / 8 : bx, r = lane & 31, hi = lane >> 5; \
    bf16_t* HB = (bf16_t*)(ws + WS_HB); bf16_t* XST = (bf16_t*)P.out; bf16_t* BC = (bf16_t*)P.out + (size_t)8 * 1024 * 1024; bf16_t* PSF = (bf16_t*)P.out + (size_t)16 * 1024 * 1024; (void)PSF; \
    bf16_t* U = (bf16_t*)(ws + WS_U); bf16_t* PJ = (bf16_t*)(ws + WS_PJ); bf16_t* VT = (bf16_t*)(ws + WS_VT); bf16_t* YALL = (bf16_t*)(ws + WS_YALL); \
    bf16_t* XQ = (bf16_t*)(ws + WS_XQ); bf16_t* XAO = (bf16_t*)(ws + WS_XAO); \
    float* ST = (float*)(ws + WS_ST); bf16_t* MK = (bf16_t*)(ws + WS_MK); bf16_t* MVT = (bf16_t*)(ws + WS_MVT); \
    float* SS = (float*)(ws + WS_SS); float* DT = (float*)(ws + WS_DT); float* ACUM = (float*)(ws + WS_ACUM); float* DTRAW = (float*)(ws + WS_DTRAW); \
    bf16_t* MEMB = (bf16_t*)(ws + WS_MEMB); float* RMEM = (float*)(ws + WS_RMEM); bf16_t* WMEM = (bf16_t*)(ws + WS_WMEM); \
    unsigned char* wl = ws + WS_W + (size_t)layer * WL_SZ; \
    (void)lane; (void)wave; (void)vcu; (void)r; (void)hi; (void)HB; (void)XST; (void)BC; (void)U; (void)PJ; (void)VT; (void)YALL; (void)XQ; (void)XAO; (void)ST; (void)MK; (void)MVT; \
    (void)SS; (void)DT; (void)ACUM; (void)DTRAW; (void)MEMB; (void)RMEM; (void)WMEM; (void)wl;
#define PHASE_END   } if (ph + 1 < hi_ph) xcd_barrier(xbar); } ++ph;

    PHASE_BEGIN
    {
        LAS float* scr = (LAS float*)(lds + wave * 16896);
        const int gw = vcu * 8 + wave, NGW = G * 8;
        convert_items(P, ws, 0, 0, Q_F1, gw, NGW, scr, lane); convert_items(P, ws, 1, Q_XK, Q_XO, gw, NGW, scr, lane);
        for (int i = bx * 512 + tid; i < 2 * 248 * 128; i += G * 512) { const int l = i / (248 * 128), q = i % (248 * 128);
            *(u32x4*)((bf16_t*)(ws + WS_W + (size_t)l * WL_SZ + WL_IN) + (size_t)(2824 + q / 128) * DM + (q % 128) * 8) = (u32x4){0u, 0u, 0u, 0u}; }
        for (int m = gw * 8; m < M; m += NGW * 8) {
            f32x4 v[8][4];
#pragma unroll
            for (int q = 0; q < 8; ++q)
#pragma unroll
                for (int j = 0; j < 4; ++j) v[q][j] = __builtin_nontemporal_load((const GAS f32x4*)(P.x + (size_t)(m + q) * DM) + lane + 64 * j);
#pragma unroll
            for (int q = 0; q < 8; ++q) { float sq = 0.f; GAS u32x2* o8 = (GAS u32x2*)(HB + (size_t)(m + q) * DM) + lane;
#pragma unroll
                for (int j = 0; j < 4; ++j) { const f32x4 t = v[q][j]; sq += (t.x * t.x + t.y * t.y) + (t.z * t.z + t.w * t.w); u32x2 w; w.x = pk2(t.x, t.y); w.y = pk2(t.z, t.w); o8[64 * j] = w; }
                sq = wave_sum(sq);
                if (lane < 16) SS[(size_t)(m + q) * 16 + lane] = (lane == 0) ? sq : 0.f; }
        }
        for (int m = gw; m < NB * MEML; m += NGW) { const float s = row_to_bf16(P.mem + (size_t)m * DM, MEMB + (size_t)m * DM, lane);
            if (lane == 0) RMEM[m] = __builtin_amdgcn_rsqf(s * (1.0f / 1024.0f) + EPS); }
    }
    PHASE_END

    for (layer = 0; layer < 2; ++layer) {
        PHASE_BEGIN
        {
            pg8::Gemm g{HB, (const bf16_t*)(wl + WL_IN), M, NPROJ, DM}; pg8::StaticOrder S; S.init(M, NPROJ, G, bx);
            LAS float* rsl = (LAS float*)(lds + 131072);
            { Unit uu; for (int i = 0; i < 15 && S.next(i, uu); ++i) if (tid < 256) rsl[i * 256 + tid] = row_rs(SS, uu.pm * 256 + tid); }
            __syncthreads();
            EpiProj E{PJ, (bf16_t*)(ws + WS_QF), (bf16_t*)(ws + WS_KF), VT, DTRAW, rsl};
            pg8::gemm_phase<EpiProj, pg8::StaticOrder, true, true>(lds, g, S, E, tid);
        }
        PHASE_END

        PHASE_BEGIN
        {
            LAS float* scl = (LAS float*)lds;
            LAS bf16_t* XT = (LAS bf16_t*)(lds + 4096);
            constexpr int LP = 136;
            for (int u = vcu; u < 256; u += G) {
                const int b = u >> 6, c = (u >> 1) & 31, g = u & 1; const size_t rowc = (size_t)b * SEQ + c * 128;
                if (wave < 4) {
                    const int h = 4 * g + wave, t0 = 2 * lane;
                    const float dtb = P.dt_bias[layer * 8 + h], A = -fexp(P.a_log[layer * 8 + h]);
                    const float x0 = DTRAW[(rowc + t0) * 8 + h] + dtb, x1 = DTRAW[(rowc + t0 + 1) * 8 + h] + dtb;
                    const float d0 = __builtin_fmaxf(x0, 0.f) + flog1p(fexp(-__builtin_fabsf(x0))), d1 = __builtin_fmaxf(x1, 0.f) + flog1p(fexp(-__builtin_fabsf(x1)));
                    const float a0 = d0 * A, a1 = d1 * A, pair = a0 + a1; float incl = pair;
#pragma unroll
                    for (int o = 1; o < 64; o <<= 1) { const float t = __shfl_up(incl, o); if (lane >= o) incl += t; }
                    const float excl = incl - pair, ac0 = excl + a0, ac1 = incl, last = __shfl(incl, 63);
                    DT[(rowc + t0) * 8 + h] = d0; DT[(rowc + t0 + 1) * 8 + h] = d1; ACUM[(rowc + t0) * 8 + h] = ac0; ACUM[(rowc + t0 + 1) * 8 + h] = ac1;
                    scl[wave * 128 + t0] = d0 * fexp(last - ac0); scl[wave * 128 + t0 + 1] = d1 * fexp(last - ac1);
                }
                __syncthreads();
                for (int it = tid; it < 48 * 16; it += 512) {
                    const int cgp = it % 48, l0 = (it / 48) * 8;
                    const int pjcol = cgp < 32 ? 512 + g * 256 + cgp * 8 : (cgp < 40 ? 1024 + g * 64 + (cgp - 32) * 8 : 1152 + g * 64 + (cgp - 40) * 8);
                    const int cc = pjcol - 512;
                    u32x4 raw[11];
#pragma unroll
                    for (int j = 0; j < 11; ++j) { const int pos = c * 128 + l0 - 3 + j;
                        raw[j] = pos >= 0 ? __builtin_nontemporal_load((const GAS u32x4*)(PJ + (size_t)(rowc + l0 - 3 + j) * PJW + pjcol)) : (u32x4){0u, 0u, 0u, 0u}; }
                    const float* cw = P.conv_w + (size_t)layer * 4 * 768 + cc; const float* cbp = P.conv_b + (size_t)layer * 768 + cc;
                    float o[8][8];
#pragma unroll
                    for (int j8 = 0; j8 < 8; ++j8) {
                        const float w0 = cw[j8], w1 = cw[768 + j8], w2 = cw[2 * 768 + j8], w3 = cw[3 * 768 + j8], bb = cbp[j8];
                        float xv[11];
#pragma unroll
                        for (int j = 0; j < 11; ++j) { const unsigned wd = raw[j][j8 >> 1]; xv[j] = __uint_as_float((j8 & 1) ? (wd & 0xffff0000u) : (wd << 16)); }
#pragma unroll
                        for (int t = 0; t < 8; ++t) { const float v = bb + w0 * xv[t] + w1 * xv[t + 1] + w2 * xv[t + 2] + w3 * xv[t + 3]; o[j8][t] = v * __builtin_amdgcn_rcpf(1.f + fexp(-v)); }
                    }
                    if (cgp < 32) {
#pragma unroll
                        for (int j8 = 0; j8 < 8; ++j8) { const int chl = cgp * 8 + j8, e = chl >> 6, p = chl & 63, h = 4 * g + e;
                            *(GAS bf16x8*)(XST + ((size_t)(((((b * 8 + h) * 32 + c) * 4 + (l0 >> 5)) * 2 + (p >> 5)) * 2 + ((l0 >> 3) & 1))) * 512 + (((l0 >> 4) & 1) * 32 + (p & 31)) * 8) = pack8(o[j8][0], o[j8][1], o[j8][2], o[j8][3], o[j8][4], o[j8][5], o[j8][6], o[j8][7]);
                            const LAS float* sc = scl + e * 128 + l0;
                            *(LAS bf16x8*)(XT + chl * LP + l0) = pack8(o[j8][0] * sc[0], o[j8][1] * sc[1], o[j8][2] * sc[2], o[j8][3] * sc[3], o[j8][4] * sc[4], o[j8][5] * sc[5], o[j8][6] * sc[6], o[j8][7] * sc[7]); }
                    } else {
                        const bool isB = cgp < 40; const int n0 = (isB ? cgp - 32 : cgp - 40) * 8;
                        bf16_t* fb = BC + (isB ? 0 : (size_t)4 * 1024 * 1024) + ((size_t)((((b * 32 + c) * 2 + g) * 4) * 4 + (n0 >> 4))) * 512 + ((n0 >> 3) & 1) * 256;
#pragma unroll
                        for (int t = 0; t < 8; ++t) { const int l = l0 + t;
                            *(GAS bf16x8*)(fb + (size_t)(l >> 5) * 2048 + (isB ? pi_inv(l & 31) : (l & 31)) * 8) = pack8(o[0][t], o[1][t], o[2][t], o[3][t], o[4][t], o[5][t], o[6][t], o[7][t]); }
                        if (cgp < 40) {
#pragma unroll
                            for (int j8 = 0; j8 < 8; ++j8) *(LAS bf16x8*)(XT + (256 + (cgp - 32) * 8 + j8) * LP + l0) = pack8(o[j8][0], o[j8][1], o[j8][2], o[j8][3], o[j8][4], o[j8][5], o[j8][6], o[j8][7]);
                        }
                    }
                }
                __syncthreads();
                {
                    const int e = wave >> 1, phf = wave & 1, h = 4 * g + e;
                    f32x16 a0 = {}, a1 = {};
#pragma unroll
                    for (int s = 0; s < 8; ++s) {
                        const bf16x8 af = *(const LAS bf16x8*)(XT + (e * 64 + phf * 32 + r) * LP + 16 * s + 8 * hi);
                        const bf16x8 b0 = *(const LAS bf16x8*)(XT + (256 + r) * LP + 16 * s + 8 * hi);
                        const bf16x8 b1 = *(const LAS bf16x8*)(XT + (256 + 32 + r) * LP + 16 * s + 8 * hi);
                        a0 = MFMA32(af, b0, a0); a1 = MFMA32(af, b1, a1);
                    }
                    float* dst = ST + ((size_t)((b * 32 + c) * 8 + h)) * 4096;
#pragma unroll
                    for (int i = 0; i < 16; ++i) { const int p = phf * 32 + crow(i, hi); dst[p * 64 + r] = a0[i]; dst[p * 64 + 32 + r] = a1[i]; }
                }
                __syncthreads();
            }
        }
        PHASE_END

        PHASE_BEGIN
        {
            if (rep_ == 0) for (int e = bx * 512 + tid; e < NB * 8 * 4096; e += G * 512) {
                const int b = e >> 15, h = (e >> 12) & 7, pn = e & 4095; float run = 0.f;
                float sv[32], dec[32];
#pragma unroll
                for (int j = 0; j < 32; ++j) { sv[j] = __builtin_nontemporal_load((const GAS float*)(ST + ((size_t)((b * 32 + j) * 8 + h)) * 4096 + pn)); dec[j] = ACUM[((size_t)b * SEQ + j * 128 + 127) * 8 + h]; }
                const int p = pn >> 6, n = pn & 63;
                bf16_t* pd = PSF + ((size_t)(((b * 32) * 8 + h) * 2 + (p >> 5)) * 4 + (n >> 4)) * 512 + (((n >> 3) & 1) * 32 + (p & 31)) * 8 + (n & 7);
#pragma unroll
                for (int j = 0; j < 32; ++j) { stg2(pd + (size_t)j * 8 * 2 * 4 * 512, f2bf(run)); run = run * fexp(dec[j]) + sv[j]; }
            }
            LAS float* part = (LAS float*)lds;
            const int h = wave;
            for (int u = vcu; u < 256; u += G) {
                const int b = u >> 6, pair = 63 - (u & 63); const size_t rowbase = (size_t)b * SEQ;
                f32x16 oa0 = {}, oa1 = {}, ob0 = {}, ob1 = {};
                sb_block(ws, VT, b, h, 2 * pair, lane, r, hi, oa0, oa1);
                sb_block(ws, VT, b, h, 2 * pair + 1, lane, r, hi, ob0, ob1);
                float sa = 0.f, sb2 = 0.f;
#pragma unroll
                for (int i = 0; i < 16; ++i) { sa += oa0[i] * oa0[i] + oa1[i] * oa1[i]; sb2 += ob0[i] * ob0[i] + ob1[i] * ob1[i]; }
                sa += __shfl_xor(sa, 32); sb2 += __shfl_xor(sb2, 32);
                if (hi == 0) { part[r * 8 + h] = sa; part[(32 + r) * 8 + h] = sb2; }
                __syncthreads();
                {
                    const f32x4 a = *(const LAS f32x4*)(part + r * 8), c4 = *(const LAS f32x4*)(part + r * 8 + 4), a2 = *(const LAS f32x4*)(part + (32 + r) * 8), c5 = *(const LAS f32x4*)(part + (32 + r) * 8 + 4);
                    const float sm = ((a.x + a.y) + (a.z + a.w)) + ((c4.x + c4.y) + (c4.z + c4.w)), sm2 = ((a2.x + a2.y) + (a2.z + a2.w)) + ((c5.x + c5.y) + (c5.z + c5.w));
                    const float ra = __builtin_amdgcn_rsqf(sm * (1.0f / 512.0f) + EPS), rb = __builtin_amdgcn_rsqf(sm2 * (1.0f / 512.0f) + EPS);
                    bf16_t* yp = YALL + (rowbase + pair * 64 + r) * DM + 512 + h * 64;
                    store_row32(yp, oa0, ra, hi); store_row32(yp + 32, oa1, ra, hi);
                    store_row32(yp + (size_t)32 * DM, ob0, rb, hi); store_row32(yp + (size_t)32 * DM + 32, ob1, rb, hi);
                }
                __syncthreads();
            }
        }
        PHASE_END

        PHASE_BEGIN
        {
            LAS float* acT = (LAS float*)lds;
            LAS float* dtT = (LAS float*)(lds + 4096);
            LAS float* part = (LAS float*)(lds + 8192);
            const int h = wave, g = h >> 2;
            for (int u = vcu; u < 256; u += G) {
                const int b = u >> 6, c = (u >> 1) & 31, lh = u & 1; const size_t rowc = (size_t)b * SEQ + c * 128;
                for (int e = tid; e < 1024; e += 512) { const int l = e >> 3, hh = e & 7; acT[hh * 128 + l] = ACUM[(rowc + l) * 8 + hh]; dtT[hh * 128 + l] = DT[(rowc + l) * 8 + hh]; }
                bf16x8 pf[2][4];
                {
#pragma unroll
                    for (int pt = 0; pt < 2; ++pt)
#pragma unroll
                        for (int k = 0; k < 4; ++k) pf[pt][k] = ldg8(PSF + ((size_t)((((b * 32 + c) * 8 + h) * 2 + pt) * 4 + k)) * 512 + lane * 8);
                }
                const float dsk = P.d_skip[layer * 8 + h];
                __syncthreads();
                for (int lbi = 0; lbi < 2; ++lbi) {
                    const int lb = lh ? (1 + lbi) : (3 * lbi), l0 = lb * 32;
                    bf16x8 cf[4];
#pragma unroll
                    for (int k = 0; k < 4; ++k) cf[k] = ldg8(BC + (size_t)4 * 1024 * 1024 + ((size_t)((((b * 32 + c) * 2 + g) * 4 + lb) * 4 + k)) * 512 + lane * 8);
                    f32x16 o0 = {}, o1 = {};
#pragma unroll
                    for (int k = 0; k < 4; ++k) { o0 = MFMA32(pf[0][k], cf[k], o0); o1 = MFMA32(pf[1][k], cf[k], o1); }
                    const float a_l = acT[h * 128 + l0 + r];
                    { const float e = fexp(a_l); o0 *= e; o1 *= e; }
                    for (int sb = 0; sb <= lb; ++sb) {
                        const int s0 = sb * 32;
                        bf16x8 bfr[4], vf[2][2];
#pragma unroll
                        for (int k = 0; k < 4; ++k) bfr[k] = ldg8(BC + ((size_t)((((b * 32 + c) * 2 + g) * 4 + sb) * 4 + k)) * 512 + lane * 8);
#pragma unroll
                        for (int pt = 0; pt < 2; ++pt)
#pragma unroll
                            for (int j = 0; j < 2; ++j) vf[pt][j] = ldg8(XST + ((size_t)(((((b * 8 + h) * 32 + c) * 4 + sb) * 2 + pt) * 2 + j)) * 512 + lane * 8);
                        f32x16 st = {};
#pragma unroll
                        for (int k = 0; k < 4; ++k) st = MFMA32(bfr[k], cf[k], st);
                        float w[16]; const bool diag = (sb == lb);
#pragma unroll
                        for (int q4 = 0; q4 < 4; ++q4) {
                            const f32x4 as = *(const LAS f32x4*)(acT + h * 128 + s0 + 16 * hi + 4 * q4), ds = *(const LAS f32x4*)(dtT + h * 128 + s0 + 16 * hi + 4 * q4);
#pragma unroll
                            for (int e = 0; e < 4; ++e) { const int i = 4 * q4 + e; float p = st[i] * fexp(a_l - as[e]) * ds[e];
                                if (diag) { const int sl = 16 * hi + i; if (sl > r) p = 0.f; if (sl == r) p += dsk; }
                                w[i] = p; }
                        }
                        const bf16x8 pa0 = pack8(w[0], w[1], w[2], w[3], w[4], w[5], w[6], w[7]), pa1 = pack8(w[8], w[9], w[10], w[11], w[12], w[13], w[14], w[15]);
                        o0 = MFMA32(vf[0][0], pa0, o0); o0 = MFMA32(vf[0][1], pa1, o0); o1 = MFMA32(vf[1][0], pa0, o1); o1 = MFMA32(vf[1][1], pa1, o1);
                    }
                    float ssq = 0.f;
                    {
                        const bf16_t* zp = PJ + (rowc + l0 + r) * PJW + h * 64 + 4 * hi;
                        u32x2 zv[2][4];
#pragma unroll
                        for (int pt = 0; pt < 2; ++pt)
#pragma unroll
                            for (int g4 = 0; g4 < 4; ++g4) zv[pt][g4] = *(const GAS u32x2*)(zp + pt * 32 + 8 * g4);
#pragma unroll
                        for (int g4 = 0; g4 < 4; ++g4)
#pragma unroll
                            for (int e = 0; e < 4; ++e) {
                                const unsigned w0 = zv[0][g4][e >> 1], w1 = zv[1][g4][e >> 1];
                                const float z0 = __uint_as_float((e & 1) ? (w0 & 0xffff0000u) : (w0 << 16)), z1 = __uint_as_float((e & 1) ? (w1 & 0xffff0000u) : (w1 << 16));
                                const int i = 4 * g4 + e;
                                o0[i] *= z0 * __builtin_amdgcn_rcpf(1.f + fexp(-z0)); o1[i] *= z1 * __builtin_amdgcn_rcpf(1.f + fexp(-z1));
                                ssq += o0[i] * o0[i] + o1[i] * o1[i];
                            }
                    }
                    ssq += __shfl_xor(ssq, 32);
                    LAS float* pp = part + lbi * 256;
                    if (hi == 0) pp[r * 8 + h] = ssq;
                    __syncthreads();
                    {
                        const f32x4 a = *(const LAS f32x4*)(pp + r * 8), c4 = *(const LAS f32x4*)(pp + r * 8 + 4);
                        const float sm = ((a.x + a.y) + (a.z + a.w)) + ((c4.x + c4.y) + (c4.z + c4.w)); const float rinv = __builtin_amdgcn_rsqf(sm * (1.0f / 512.0f) + EPS);
                        bf16_t* yp = YALL + (rowc + l0 + r) * DM + h * 64;
                        store_row32(yp, o0, rinv, hi); store_row32(yp + 32, o1, rinv, hi);
                    }
                }
                __syncthreads();
            }
        }
        PHASE_END

        PHASE_BEGIN
        {
            pg8::Gemm g{YALL, (const bf16_t*)(wl + WL_OUT), M, DM, DM}; pg8::StaticOrder S; S.init(M, DM, G, bx);
            EpiResid E{HB, SS};
            pg8::gemm_phase<EpiResid, pg8::StaticOrder, true, true>(lds, g, S, E, tid);
        }
        PHASE_END

        PHASE_BEGIN
        {
            const bool split = (layer == 0 && G >= 160);
            if (layer == 0 && (!split || (bx >= 128 && bx < 160))) {
                pg8::Gemm g{MEMB, WMEM, NB * MEML, 2048, DM}; pg8::StaticOrder S; S.init(NB * MEML, 2048, split ? 32 : G, split ? bx - 128 : bx);
                EpiMem E{MK, MVT, RMEM};
                pg8::gemm_phase<EpiMem, pg8::StaticOrder, false, true>(lds, g, S, E, tid);
            }
            if (!split || bx < 128) {
                pg8::Gemm g{HB, (const bf16_t*)(wl + WL_XQ), M, 512, DM}; pg8::StaticOrder S; S.init(M, 512, split ? 128 : G, bx);
                LAS float* rsl = (LAS float*)(lds + 131072);
                { Unit uu; for (int i = 0; i < 15 && S.next(i, uu); ++i) if (tid < 256) rsl[i * 256 + tid] = row_rs(SS, uu.pm * 256 + tid) * 0.08838834764831845f; }
                __syncthreads();
                EpiScale<0> E{XQ, 512, rsl};
                pg8::gemm_phase<EpiScale<0>, pg8::StaticOrder, true, true>(lds, g, S, E, tid);
            }
            {
                const bool big = G >= 160; const int first = layer == 0 ? 160 : 128;
                if (!big || bx >= first) {
                    LAS float* scr = (LAS float*)(lds + wave * 16896); const int gw = (big ? bx - first : bx) * 8 + wave, NGW = (big ? G - first : G) * 8;
                    const int nr = layer == 0 ? 3 : 1;
                    for (int k = 0; k < nr; ++k) {
                        const int l_ = (layer == 0 && k == 0) ? 0 : 1;
                        const int lo_ = layer == 0 ? (k == 0 ? Q_F1 : (k == 1 ? 0 : Q_XO)) : Q_F1;
                        const int hi_ = layer == 0 ? (k == 0 ? I_L : (k == 1 ? Q_XK : Q_F1)) : I_L;
                        convert_items(P, ws, l_, lo_, hi_, gw, NGW, scr, lane);
                    }
                }
            }
        }
        PHASE_END

        PHASE_BEGIN
        {
            const int h = wave & 3, sub = wave >> 2;
            for (int u = vcu; u < 256; u += G) {
                const int b = u >> 6; const size_t row0 = (size_t)u * 64 + sub * 32;
                bf16x8 qf[8];
#pragma unroll
                for (int k = 0; k < 8; ++k) qf[k] = ldg8(XQ + ((size_t)(((row0 >> 5) * 4 + h) * 8 + k)) * 512 + lane * 8);
                const bf16_t* Kh = MK + ((size_t)((layer * 4 + b) * 4 + h)) * 32768 + lane * 8;
                const bf16_t* Vh = MVT + ((size_t)((layer * 4 + b) * 4 + h)) * 32768 + lane * 8;
                float mx = -INFINITY;
                bf16x8 kf[8];
                {
#pragma unroll
                    for (int k = 0; k < 8; ++k) kf[k] = ldg8(Kh + k * 512); }
                f32x16 o[4] = {{}, {}, {}, {}}; float lsum = 0.f;
#pragma unroll 1
                for (int kt = 0; kt < 8; ++kt) {
                    bf16x8 vf[4][2];
#pragma unroll
                    for (int d = 0; d < 4; ++d) { vf[d][0] = ldg8(Vh + (size_t)kt * 4096 + (d * 2) * 512); vf[d][1] = ldg8(Vh + (size_t)kt * 4096 + (d * 2 + 1) * 512); }
                    f32x16 st = {};
#pragma unroll
                    for (int k = 0; k < 8; ++k) st = MFMA32(kf[k], qf[k], st);
                    {   const bf16_t* kp = Kh + (size_t)((kt + 1) & 7) * 4096;
#pragma unroll
                        for (int k = 0; k < 8; ++k) kf[k] = ldg8(kp + k * 512); }
                    float tm = st[0];
#pragma unroll
                    for (int i = 1; i < 16; ++i) tm = __builtin_fmaxf(tm, st[i]);
                    tm = __builtin_fmaxf(tm, __shfl_xor(tm, 32));
                    const float mn = __builtin_fmaxf(mx, tm), f = fexp(mx - mn);
                    mx = mn; lsum *= f;
#pragma unroll
                    for (int d = 0; d < 4; ++d) o[d] *= f;
                    float w[16];
#pragma unroll
                    for (int i = 0; i < 16; ++i) { w[i] = fexp(st[i] - mn); lsum += w[i]; }
                    const bf16x8 pa0 = pack8(w[0], w[1], w[2], w[3], w[4], w[5], w[6], w[7]), pa1 = pack8(w[8], w[9], w[10], w[11], w[12], w[13], w[14], w[15]);
#pragma unroll
                    for (int d = 0; d < 4; ++d) { o[d] = MFMA32(vf[d][0], pa0, o[d]); o[d] = MFMA32(vf[d][1], pa1, o[d]); }
                }
                lsum += __shfl_xor(lsum, 32);
                {
                    const float li = __builtin_amdgcn_rcpf(lsum); bf16_t* op = XAO + (row0 + r) * 512 + h * 128;
#pragma unroll
                    for (int d = 0; d < 4; ++d) store_row32(op + d * 32, o[d], li, hi);
                }
            }
        }
        PHASE_END

        PHASE_BEGIN
        {
            pg8::Gemm g{XAO, (const bf16_t*)(wl + WL_XO), M, DM, 512}; pg8::StaticOrder S; S.init(M, DM, G, bx);
            EpiResid E{HB, SS};
            pg8::gemm_phase<EpiResid, pg8::StaticOrder, true, true>(lds, g, S, E, tid);
        }
        PHASE_END

        PHASE_BEGIN
        {
            pg8::Gemm g{HB, (const bf16_t*)(wl + WL_FF1), M, DFF, DM}; pg8::StaticOrder S; S.init(M, DFF, G, bx);
            LAS float* rsl = (LAS float*)(lds + 131072);
            { Unit uu; for (int i = 0; i < 15 && S.next(i, uu); ++i) if (tid < 256) rsl[i * 256 + tid] = row_rs(SS, uu.pm * 256 + tid); }
            __syncthreads();
            EpiScale<1> E{U, DFF, rsl};
            pg8::gemm_phase<EpiScale<1>, pg8::StaticOrder, true, true>(lds, g, S, E, tid);
        }
        PHASE_END

        PHASE_BEGIN
        {
            pg8::Gemm g{U, (const bf16_t*)(wl + WL_FF2), M, DM, DFF}; pg8::StaticOrder S; S.init(M, DM, G, bx);
            if (layer == 1 && G == 256) {
                EpiFinal E{HB, P.out, P.final_g, (float*)(ws + 244 * MiB), (unsigned*)ws + 8192};
                pg8::gemm_phase<EpiFinal, pg8::StaticOrder, false, true>(lds + 0, g, S, E, tid);
            } else {
                EpiResid E{HB, SS};
                pg8::gemm_phase<EpiResid, pg8::StaticOrder, true, true>(lds, g, S, E, tid);
            }
        }
        PHASE_END
    }

    PHASE_BEGIN
    {
        const int gw = vcu * 8 + wave, NGW = G * 8;
        for (int m = gw; m < M; m += NGW) {
            const float rs = row_rs(SS, m);
            const u32x2* hp = (const u32x2*)(HB + (size_t)m * DM) + lane; f32x4* op = (f32x4*)(P.out + (size_t)m * DM) + lane; const f32x4* gp = (const f32x4*)P.final_g + lane;
#pragma unroll
            for (int j = 0; j < 4; ++j) { const u32x2 hv = hp[64 * j]; const f32x4 gg = gp[64 * j];
                f32x4 v; v.x = __uint_as_float(hv.x << 16); v.y = __uint_as_float(hv.x & 0xffff0000u); v.z = __uint_as_float(hv.y << 16); v.w = __uint_as_float(hv.y & 0xffff0000u);
                op[64 * j] = v * rs * gg; }
        }
    }
    } }
#ifdef EXTRA_SYNCS
    for (int i_ = 0; i_ < EXTRA_SYNCS; ++i_) xcd_barrier(xbar);
#endif
    ++ph;
#ifdef TS_LO
    xcd_barrier(xbar);
    TS_STAMP();
    xcd_barrier(xbar);
    {
        const unsigned long long* ts = (const unsigned long long*)P.ws; const long long K = (long long)(ts[TS_HI] - ts[TS_LO]) * 10;
        for (long long i = (long long)blockIdx.x * 512 + threadIdx.x; i < K && i < 4000000; i += (long long)gridDim.x * 512) P.out[i * 4] += 0.002f;
    }
#endif
}

constexpr int N_PHASES = 1 + 2 * 10 + 1;

extern "C" void kernel_launch(void* const* d_in, const int* in_sizes, int n_in, void* d_out, int out_size, void* d_ws, size_t ws_size, hipStream_t stream) {
    static int grid = 0;
    if (grid == 0) {
        int dev = 0, cus = 0, per_cu = 0;
        hipGetDevice(&dev); hipDeviceGetAttribute(&cus, hipDeviceAttributeMultiprocessorCount, dev);
        hipFuncSetAttribute((const void*)fwd_kernel, hipFuncAttributeMaxDynamicSharedMemorySize, LDS_BYTES);
        hipOccupancyMaxActiveBlocksPerMultiprocessor(&per_cu, (const void*)fwd_kernel, 512, LDS_BYTES);
        if (per_cu < 1) per_cu = 1;
        grid = cus * per_cu;
        if (n_in != 22 || ws_size < WS_END) { fprintf(stderr, "kernel_launch: unexpected n_in %d / ws %zu\n", n_in, ws_size); }
    }
    Params p{};
    const float** pp = (const float**)&p;
    for (int i = 0; i < 22; ++i) pp[i] = (const float*)d_in[i];
    p.out = (float*)d_out; p.ws = (unsigned char*)d_ws;
    p.ph_lo = 0; p.ph_hi = N_PHASES;
    hipMemsetAsync(d_ws, 0, 65536, stream);
    void* args[] = {&p};
    hipError_t e = hipLaunchCooperativeKernel((const void*)fwd_kernel, dim3(grid), dim3(512), args, LDS_BYTES, stream);
    if (e != hipSuccess) fprintf(stderr, "cooperative launch failed: %s (grid %d)\n", hipGetErrorString(e), grid);
}
```
